# Optimizing an MI355X kernel written in HIP

```python
import math
import jax
import jax.numpy as jnp
from jax import lax
import numpy as np

D_MODEL = 1024
BATCH = 4
SEQ = 4096
DEPTH = 2

MEM_LEN = 256
HEAD_DIM = 64
MIX_WIDTH = 2 * D_MODEL
SSD_WIDTH = MIX_WIDTH // 2
RWKV_WIDTH = MIX_WIDTH - SSD_WIDTH
SSD_HEADS = SSD_WIDTH // HEAD_DIM
SSD_GROUPS = 2
SSD_STATE = 128
SSD_CONV = 4
SSD_CHUNK = 128
SSD_XBC = SSD_WIDTH + 2 * SSD_GROUPS * SSD_STATE
SSD_IN = SSD_WIDTH + SSD_XBC + SSD_HEADS
RWKV_HEADS = RWKV_WIDTH // HEAD_DIM
RWKV_DECAY_LORA = 64
RWKV_ICLR_LORA = 64
RWKV_GATE_LORA = 128
RWKV_IN = 3 * RWKV_WIDTH + RWKV_DECAY_LORA + RWKV_ICLR_LORA + RWKV_GATE_LORA
EVEN_IN = SSD_IN + RWKV_IN
MOBA_HEADS = D_MODEL // HEAD_DIM
MOBA_BLOCK = 256
MOBA_TOPK = 3
MOBA_QBLOCK = 128
XATTN_HEADS = 4
XATTN_HEAD_DIM = D_MODEL // XATTN_HEADS
FFN_RAW = -(-8 * D_MODEL // 3)
FFN_HIDDEN = -(-FFN_RAW // 256) * 256
N_EVEN = (DEPTH + 1) // 2
N_ODD = DEPTH // 2
DEEPNORM_ALPHA = (2 * DEPTH) ** 0.25
DEEPNORM_BETA = (8 * DEPTH) ** -0.25
LN_EPS = 1e-5
RMS_EPS = 1e-5
RWKV_LNX_EPS = 64e-5

kernel_name = "hybrid_ssd_rwkv7_moba_deepnorm"

F32 = jnp.float32


def _layer_norm(x, g, b):
    xf = x.astype(F32)
    mu = jnp.mean(xf, axis=-1, keepdims=True)
    var = jnp.mean(jnp.square(xf - mu), axis=-1, keepdims=True)
    return ((xf - mu) * lax.rsqrt(var + LN_EPS) * g + b).astype(x.dtype)


def _token_shift(s):
    return jnp.pad(s, ((0, 0), (1, 0), (0, 0)))[:, :-1]


def _causal_dwconv(u, w, b):
    k = w.shape[0]
    out = lax.conv_general_dilated(
        u, w.astype(u.dtype)[:, None, :], window_strides=(1,), padding=[(k - 1, 0)],
        dimension_numbers=("NWC", "WIO", "NWC"), feature_group_count=u.shape[-1])
    return out + b


def _ssd_chunked(xs, dt, a_neg, bm, cm):
    bsz, l, h, p = xs.shape
    g, n = bm.shape[2], bm.shape[3]
    rep = h // g
    nc = l // SSD_CHUNK
    bh = jnp.repeat(bm, rep, axis=2).reshape(bsz, nc, SSD_CHUNK, h, n)
    ch = jnp.repeat(cm, rep, axis=2).reshape(bsz, nc, SSD_CHUNK, h, n)
    xdt = (xs.astype(F32) * dt[..., None]).reshape(bsz, nc, SSD_CHUNK, h, p)
    a = (dt * a_neg).reshape(bsz, nc, SSD_CHUNK, h).transpose(0, 3, 1, 2)
    a_cum = jnp.cumsum(a, axis=-1)
    causal = jnp.tril(jnp.ones((SSD_CHUNK, SSD_CHUNK), dtype=bool))
    seg = a_cum[..., :, None] - a_cum[..., None, :]
    lmat = jnp.exp(jnp.where(causal, seg, -jnp.inf))
    cb = jnp.einsum("bclhn,bcshn->bhcls", ch, bh) * lmat
    y_diag = jnp.einsum("bhcls,bcshp->bclhp", cb, xdt)
    decay_states = jnp.exp(a_cum[..., -1:] - a_cum)
    states = jnp.einsum("bcqhn,bhcq,bcqhp->bchpn", bh, decay_states, xdt)
    chunk_decay = jnp.exp(a_cum[..., -1])

    def step(carry, inp):
        st, dec = inp
        return carry * dec[..., None, None] + st, carry

    init = jnp.zeros((bsz, h, p, n), F32)
    _, prev = lax.scan(step, init, (states.transpose(1, 0, 2, 3, 4), chunk_decay.transpose(2, 0, 1)))
    prev = prev.transpose(1, 0, 2, 3, 4)
    y_off = jnp.einsum("bclhn,bchpn,bhcl->bclhp", ch, prev, jnp.exp(a_cum))
    return (y_diag + y_off).reshape(bsz, l, h, p)


def _ssd_mixer(z, xbc, dt_raw, conv_w, conv_b, dt_bias, a_log, d_skip, norm_g):
    bsz, l, _ = z.shape
    xbc = jax.nn.silu(_causal_dwconv(xbc, conv_w, conv_b))
    xs, bm, cm = jnp.split(xbc, [SSD_WIDTH, SSD_WIDTH + SSD_GROUPS * SSD_STATE], axis=-1)
    xs = xs.reshape(bsz, l, SSD_HEADS, HEAD_DIM)
    bm = bm.reshape(bsz, l, SSD_GROUPS, SSD_STATE)
    cm = cm.reshape(bsz, l, SSD_GROUPS, SSD_STATE)
    dt = jax.nn.softplus((dt_raw + dt_bias).astype(F32))
    a_neg = -jnp.exp(a_log.astype(F32))
    y = _ssd_chunked(xs, dt, a_neg, bm, cm) + d_skip[:, None] * xs
    y = y.reshape(bsz, l, SSD_WIDTH) * jax.nn.silu(z)
    yg = y.astype(F32).reshape(bsz, l, SSD_GROUPS, SSD_WIDTH // SSD_GROUPS)
    yg = yg * lax.rsqrt(jnp.mean(jnp.square(yg), axis=-1, keepdims=True) + RMS_EPS)
    return (yg.reshape(bsz, l, SSD_WIDTH) * norm_g).astype(z.dtype)


def _rwkv7_scan(r, w, k, v, a, b):
    bsz, l, h, n = r.shape
    seq = tuple(t.transpose(1, 0, 2, 3) for t in (r, w, k, v, a, b))

    def step(s, inp):
        rt, wt, kt, vt, at, bt = inp
        sa = jnp.einsum("bhij,bhj->bhi", s, at)
        s = s * wt[:, :, None, :] + sa[..., None] * bt[:, :, None, :] + vt[..., None] * kt[:, :, None, :]
        return s, jnp.einsum("bhij,bhj->bhi", s, rt)

    _, y = lax.scan(step, jnp.zeros((bsz, h, n, n), F32), seq)
    return y.transpose(1, 0, 2, 3)


def _rwkv7_mixer(s, mu, w0, w2, a0, a2, g2, k_k, k_a, r_k, lnx_g, lnx_b):
    bsz, l, _ = s.shape
    s = s + (_token_shift(s) - s) * mu
    o1, o2, o3 = RWKV_WIDTH, 2 * RWKV_WIDTH, 3 * RWKV_WIDTH
    r, k, v, w_lo, a_lo, g_lo = jnp.split(
        s, [o1, o2, o3, o3 + RWKV_DECAY_LORA, o3 + RWKV_DECAY_LORA + RWKV_ICLR_LORA], axis=-1)
    w = -jax.nn.softplus(-(w0 + jnp.tanh(w_lo) @ w2)) - 0.5
    decay = jnp.exp(-jnp.exp(w.astype(F32)))
    a = jax.nn.sigmoid(a0 + a_lo @ a2)
    g = jax.nn.sigmoid(g_lo) @ g2
    hs = (bsz, l, RWKV_HEADS, HEAD_DIM)
    kk = (k * k_k).astype(F32).reshape(hs)
    kk = kk * lax.rsqrt(jnp.maximum(jnp.sum(kk * kk, axis=-1, keepdims=True), 1e-24))
    k = k * (1 + (a - 1) * k_a)
    rh, kh, vh, ah = [t.astype(F32).reshape(hs) for t in (r, k, v, a)]
    y = _rwkv7_scan(rh, decay.reshape(hs), kh, vh, -kk, kk * ah)
    ym = jnp.mean(y, axis=-1, keepdims=True)
    yv = jnp.mean(jnp.square(y - ym), axis=-1, keepdims=True)
    y = ((y - ym) * lax.rsqrt(yv + RWKV_LNX_EPS)).reshape(bsz, l, RWKV_WIDTH) * lnx_g + lnx_b
    bonus = jnp.sum(rh * kh * r_k, axis=-1, keepdims=True) * vh
    y = (y + bonus.reshape(bsz, l, RWKV_WIDTH)) * g
    return y.astype(s.dtype)


def _moba_attention(q, k, v):
    bsz, s, h, d = q.shape
    nb = -(-s // MOBA_BLOCK)
    pad = nb * MOBA_BLOCK - s
    q = q.transpose(0, 2, 1, 3)
    k = jnp.pad(k.transpose(0, 2, 1, 3), ((0, 0), (0, 0), (0, pad), (0, 0)))
    v = jnp.pad(v.transpose(0, 2, 1, 3), ((0, 0), (0, 0), (0, pad), (0, 0)))
    kblk = k.reshape(bsz, h, nb, MOBA_BLOCK, d)
    vblk = v.reshape(bsz, h, nb, MOBA_BLOCK, d)
    kmean = jnp.mean(kblk.astype(F32), axis=3)
    topk = min(MOBA_TOPK, nb)
    nqb = s // MOBA_QBLOCK
    qb_all = q.reshape(bsz, h, nqb, MOBA_QBLOCK, d).transpose(2, 0, 1, 3, 4)
    scale = d ** -0.5
    bi = jnp.arange(bsz)[:, None, None, None]
    hi = jnp.arange(h)[None, :, None, None]
    blk_ids = jnp.arange(nb)

    def attend(inp):
        c, qb = inp
        q_pos = c * MOBA_QBLOCK + jnp.arange(MOBA_QBLOCK)
        own = (c * MOBA_QBLOCK) // MOBA_BLOCK
        gate = jnp.einsum("bhqd,bhnd->bhqn", qb.astype(F32), kmean)
        gate = jnp.where(blk_ids < own, gate, -jnp.inf)
        _, idx = lax.top_k(gate, topk)
        sel_ok = idx < own
        kg = kblk[bi, hi, idx]
        vg = vblk[bi, hi, idx]
        s_sel = jnp.einsum("bhqd,bhqjtd->bhqjt", qb, kg).astype(F32) * scale
        s_sel = jnp.where(sel_ok[..., None], s_sel, -jnp.inf).reshape(bsz, h, MOBA_QBLOCK, topk * MOBA_BLOCK)
        k_own = lax.dynamic_slice_in_dim(k, own * MOBA_BLOCK, MOBA_BLOCK, axis=2)
        v_own = lax.dynamic_slice_in_dim(v, own * MOBA_BLOCK, MOBA_BLOCK, axis=2)
        k_pos = own * MOBA_BLOCK + jnp.arange(MOBA_BLOCK)
        s_own = jnp.einsum("bhqd,bhtd->bhqt", qb, k_own).astype(F32) * scale
        s_own = jnp.where(k_pos[None, :] <= q_pos[:, None], s_own, -jnp.inf)
        p = jax.nn.softmax(jnp.concatenate([s_sel, s_own], axis=-1), axis=-1)
        p_sel = p[..., :topk * MOBA_BLOCK].reshape(bsz, h, MOBA_QBLOCK, topk, MOBA_BLOCK).astype(v.dtype)
        p_own = p[..., topk * MOBA_BLOCK:].astype(v.dtype)
        return jnp.einsum("bhqjt,bhqjtd->bhqd", p_sel, vg) + jnp.einsum("bhqt,bhtd->bhqd", p_own, v_own)

    out = lax.map(attend, (jnp.arange(nqb), qb_all))
    return out.transpose(1, 0, 3, 2, 4).reshape(bsz, s, h * d)


def _memory_cross_attention(x, mem, wq, wkv, wo):
    bsz, s, _ = x.shape
    m = mem.shape[1]
    q = (x @ wq).reshape(bsz, s, XATTN_HEADS, XATTN_HEAD_DIM)
    k, v = jnp.split(mem @ wkv, 2, axis=-1)
    k = k.reshape(bsz, m, XATTN_HEADS, XATTN_HEAD_DIM)
    v = v.reshape(bsz, m, XATTN_HEADS, XATTN_HEAD_DIM)
    sc = jnp.einsum("bshd,bmhd->bhsm", q, k).astype(F32) * XATTN_HEAD_DIM ** -0.5
    p = jax.nn.softmax(sc, axis=-1).astype(v.dtype)
    o = jnp.einsum("bhsm,bmhd->bshd", p, v).reshape(bsz, s, D_MODEL)
    return o @ wo


def _swiglu(x, w13, w2):
    gate, up = jnp.split(x @ w13, 2, axis=-1)
    return (jax.nn.silu(gate) * up) @ w2


def setup_inputs(seed: int = 0) -> dict:
    key = jax.random.key(seed)
    ks = iter(jax.random.split(key, 40))

    def nrm(shape, scale):
        return scale * jax.random.normal(next(ks), shape, F32)

    def gain(shape):
        return 1.0 + nrm(shape, 0.02)

    x = nrm((BATCH, SEQ, D_MODEL), 1.0)
    mem = nrm((BATCH, MEM_LEN, D_MODEL), 1.0)
    even_w_in = nrm((N_EVEN, D_MODEL, EVEN_IN), D_MODEL ** -0.5)
    ssd_conv_w = nrm((N_EVEN, SSD_CONV, SSD_XBC), SSD_CONV ** -0.5)
    ssd_conv_b = nrm((N_EVEN, SSD_XBC), 0.01)
    dt0 = jnp.exp(jax.random.uniform(next(ks), (N_EVEN, SSD_HEADS), F32, math.log(1e-3), math.log(1e-1)))
    ssd_dt_bias = dt0 + jnp.log(-jnp.expm1(-dt0))
    ssd_a_log = jnp.log(jax.random.uniform(next(ks), (N_EVEN, SSD_HEADS), F32, 1.0, 16.0))
    ssd_d = 1.0 + nrm((N_EVEN, SSD_HEADS), 0.1)
    ssd_norm_g = gain((N_EVEN, SSD_WIDTH))
    rwkv_mu = jax.random.uniform(next(ks), (N_EVEN, RWKV_IN), F32, 0.0, 1.0)
    rwkv_w0 = jnp.linspace(-6.5, -1.5, RWKV_WIDTH, dtype=F32)[None, :] + nrm((N_EVEN, RWKV_WIDTH), 0.1)
    rwkv_w2 = nrm((N_EVEN, RWKV_DECAY_LORA, RWKV_WIDTH), 0.1 * RWKV_DECAY_LORA ** -0.5)
    rwkv_a0 = nrm((N_EVEN, RWKV_WIDTH), 0.1)
    rwkv_a2 = nrm((N_EVEN, RWKV_ICLR_LORA, RWKV_WIDTH), 0.1 * RWKV_ICLR_LORA ** -0.5)
    rwkv_g2 = nrm((N_EVEN, RWKV_GATE_LORA, RWKV_WIDTH), RWKV_GATE_LORA ** -0.5)
    rwkv_k_k = 0.85 + nrm((N_EVEN, RWKV_WIDTH), 0.05)
    rwkv_k_a = 1.0 + nrm((N_EVEN, RWKV_WIDTH), 0.05)
    rwkv_r_k = nrm((N_EVEN, RWKV_HEADS, HEAD_DIM), 0.1)
    rwkv_lnx_g = gain((N_EVEN, RWKV_WIDTH))
    rwkv_lnx_b = nrm((N_EVEN, RWKV_WIDTH), 0.02)
    even_w_out = nrm((N_EVEN, SSD_WIDTH + RWKV_WIDTH, D_MODEL), DEEPNORM_BETA * (SSD_WIDTH + RWKV_WIDTH) ** -0.5)
    odd_w_qkv = nrm((N_ODD, D_MODEL, 3 * D_MODEL), D_MODEL ** -0.5)
    odd_w_out = nrm((N_ODD, D_MODEL, D_MODEL), DEEPNORM_BETA * D_MODEL ** -0.5)
    ln_mix_g = gain((DEPTH, D_MODEL))
    ln_mix_b = nrm((DEPTH, D_MODEL), 0.02)
    xa_wq = nrm((DEPTH, D_MODEL, D_MODEL), D_MODEL ** -0.5)
    xa_wkv = nrm((DEPTH, D_MODEL, 2 * D_MODEL), D_MODEL ** -0.5)
    xa_wo = nrm((DEPTH, D_MODEL, D_MODEL), DEEPNORM_BETA * D_MODEL ** -0.5)
    ln_xa_g = gain((DEPTH, D_MODEL))
    ln_xa_b = nrm((DEPTH, D_MODEL), 0.02)
    ffn_w13 = nrm((DEPTH, D_MODEL, 2 * FFN_HIDDEN), D_MODEL ** -0.5)
    ffn_w2 = nrm((DEPTH, FFN_HIDDEN, D_MODEL), DEEPNORM_BETA * FFN_HIDDEN ** -0.5)
    ln_ffn_g = gain((DEPTH, D_MODEL))
    ln_ffn_b = nrm((DEPTH, D_MODEL), 0.02)
    return {
        "x": x, "mem": mem, "even_w_in": even_w_in, "ssd_conv_w": ssd_conv_w,
        "ssd_conv_b": ssd_conv_b, "ssd_dt_bias": ssd_dt_bias, "ssd_a_log": ssd_a_log,
        "ssd_d": ssd_d, "ssd_norm_g": ssd_norm_g, "rwkv_mu": rwkv_mu, "rwkv_w0": rwkv_w0,
        "rwkv_w2": rwkv_w2, "rwkv_a0": rwkv_a0, "rwkv_a2": rwkv_a2, "rwkv_g2": rwkv_g2,
        "rwkv_k_k": rwkv_k_k, "rwkv_k_a": rwkv_k_a, "rwkv_r_k": rwkv_r_k,
        "rwkv_lnx_g": rwkv_lnx_g, "rwkv_lnx_b": rwkv_lnx_b, "even_w_out": even_w_out,
        "odd_w_qkv": odd_w_qkv, "odd_w_out": odd_w_out, "ln_mix_g": ln_mix_g,
        "ln_mix_b": ln_mix_b, "xa_wq": xa_wq, "xa_wkv": xa_wkv, "xa_wo": xa_wo,
        "ln_xa_g": ln_xa_g, "ln_xa_b": ln_xa_b, "ffn_w13": ffn_w13, "ffn_w2": ffn_w2,
        "ln_ffn_g": ln_ffn_g, "ln_ffn_b": ln_ffn_b,
    }


def reference(x, mem, even_w_in, ssd_conv_w, ssd_conv_b, ssd_dt_bias, ssd_a_log, ssd_d,
              ssd_norm_g, rwkv_mu, rwkv_w0, rwkv_w2, rwkv_a0, rwkv_a2, rwkv_g2, rwkv_k_k,
              rwkv_k_a, rwkv_r_k, rwkv_lnx_g, rwkv_lnx_b, even_w_out, odd_w_qkv, odd_w_out,
              ln_mix_g, ln_mix_b, xa_wq, xa_wkv, xa_wo, ln_xa_g, ln_xa_b, ffn_w13, ffn_w2,
              ln_ffn_g, ln_ffn_b):
    bsz, s, _ = x.shape
    for layer in range(DEPTH):
        j = layer // 2
        if layer % 2 == 0:
            proj = x @ even_w_in[j]
            z, xbc, dt_raw, rw = jnp.split(proj, [SSD_WIDTH, SSD_WIDTH + SSD_XBC, SSD_IN], axis=-1)
            y_ssd = _ssd_mixer(z, xbc, dt_raw, ssd_conv_w[j], ssd_conv_b[j], ssd_dt_bias[j],
                               ssd_a_log[j], ssd_d[j], ssd_norm_g[j])
            y_rwkv = _rwkv7_mixer(rw, rwkv_mu[j], rwkv_w0[j], rwkv_w2[j], rwkv_a0[j], rwkv_a2[j],
                                  rwkv_g2[j], rwkv_k_k[j], rwkv_k_a[j], rwkv_r_k[j],
                                  rwkv_lnx_g[j], rwkv_lnx_b[j])
            mix = jnp.concatenate([y_ssd, y_rwkv], axis=-1) @ even_w_out[j]
        else:
            q, k, v = jnp.split(x @ odd_w_qkv[j], 3, axis=-1)
            hs = (bsz, s, MOBA_HEADS, HEAD_DIM)
            mix = _moba_attention(q.reshape(hs), k.reshape(hs), v.reshape(hs)) @ odd_w_out[j]
        x = _layer_norm(DEEPNORM_ALPHA * x + mix, ln_mix_g[layer], ln_mix_b[layer])
        xa = _memory_cross_attention(x, mem, xa_wq[layer], xa_wkv[layer], xa_wo[layer])
        x = _layer_norm(DEEPNORM_ALPHA * x + xa, ln_xa_g[layer], ln_xa_b[layer])
        ff = _swiglu(x, ffn_w13[layer], ffn_w2[layer])
        x = _layer_norm(DEEPNORM_ALPHA * x + ff, ln_ffn_g[layer], ln_ffn_b[layer])
    return x
```

```cpp
#include <hip/hip_runtime.h>
#include <hip/hip_cooperative_groups.h>
#include <stdint.h>
#include <cstdio>
namespace cg = cooperative_groups;
#define DI __device__ __forceinline__
typedef unsigned short u16;
using bf16x8 = __attribute__((ext_vector_type(8))) short;
using f32x16 = __attribute__((ext_vector_type(16))) float;
using u32x4 = __attribute__((ext_vector_type(4))) unsigned;
#define FRESH_TID() ({ int t_ = (int)threadIdx.x; asm volatile("" : "+v"(t_)); t_; })
#define MFMA(a, b, c) __builtin_amdgcn_mfma_f32_32x32x16_bf16((a), (b), (c), 0, 0, 0)

constexpr int NB_ = 4, S_ = 4096, D_ = 1024, M_ = NB_ * S_;
constexpr int EVEN_IN = 5904, EVEN_IN_PAD = 6016, FFN_H = 2816;
constexpr float ALPHA = 1.41421356237309515f;
constexpr size_t MiB = 1ull << 20;
constexpr size_t OFF_RW = 0, OFF_XBC = 104 * MiB, OFF_Z = 152 * MiB, OFF_WIN = 184 * MiB;
constexpr size_t OFF_WOUT = OFF_WIN + (size_t)EVEN_IN_PAD * 1024 * 2;
constexpr size_t OFF_XB = OFF_WOUT + 4 * MiB;
constexpr size_t OFF_DT = OFF_XB + 32 * MiB;
constexpr size_t OFF_LIN = OFF_DT + 1 * MiB;
constexpr size_t OFF_MEMB = OFF_LIN + 8 * MiB;
constexpr size_t OFF_XAK = OFF_MEMB + 2 * MiB;
constexpr size_t OFF_XAVT = OFF_XAK + 4 * MiB;
constexpr size_t OFF_KMEAN = OFF_XAVT + 4 * MiB;
constexpr size_t OFF_CDEC = OFF_KMEAN + MiB / 4;
constexpr size_t OFF_LORAW = OFF_CDEC + MiB / 4;
constexpr size_t OFF_STATES = OFF_XB, OFF_GG = OFF_XB, OFF_YR = OFF_XBC;
constexpr size_t DO_XT = 0, DO_BM = 32 * MiB, DO_BMT = 40 * MiB, DO_CM = 48 * MiB, DO_WE = 0, DO_AA = 32 * MiB;
constexpr size_t OFF_QKV1 = 0, OFF_OUT1 = 6 * MiB, OFF_LW = 8 * MiB, LW_STRIDE = 49 * MiB / 2;
constexpr size_t LW_WQ = 0, LW_WKV = 2 * MiB, LW_WO = 6 * MiB, LW_W13 = 8 * MiB, LW_W2F = 19 * MiB;
constexpr size_t OFF_S0 = 57 * MiB, OFF_S1 = 89 * MiB, OFF_S2 = 121 * MiB, OFF_S3 = 153 * MiB;

#ifndef RPT_SCAN
#define RPT_SCAN 1
#endif
#ifndef RPT_MOBA
#define RPT_MOBA 1
#endif
#ifndef RPT_FFN
#define RPT_FFN 1
#endif

#define XB_TMO      128
#define XB_XCNT(j)  (256  + 64 * (j))
#define XB_XSUB(j)  (1280 + 64 * (j))
#define XB_XGEN(j)  (2304 + 64 * (j))
#define XB_TOP      3328
#define XB_TOPGEN   3392
#define XCD_BAR_WORDS 3456
#define XB_SPIN_CAP (1u << 18)
#define LAS __attribute__((address_space(3)))
DI unsigned xb_ld(unsigned* p)              { return __hip_atomic_load(p, __ATOMIC_RELAXED, __HIP_MEMORY_SCOPE_AGENT); }
DI unsigned xb_add(unsigned* p, unsigned v) { return __hip_atomic_fetch_add(p, v, __ATOMIC_RELAXED, __HIP_MEMORY_SCOPE_AGENT); }
DI unsigned xb_xcc_id() { return (unsigned)__builtin_amdgcn_s_getreg((3 << 11) | 20) & 0xFu; }
#define XB_SPIN(cond, bar) do { unsigned _sp = 0; while (cond) { __builtin_amdgcn_s_sleep(1); \
    if ((++_sp & 255u) == 0u) { if (xb_ld(&(bar)[XB_TMO])) break; if (_sp > XB_SPIN_CAP) { atomicAdd(&(bar)[XB_TMO], 1u); break; } } } } while (0)
struct XcdBarrier { unsigned* bar; unsigned x; volatile LAS unsigned* st; };
DI XcdBarrier xcd_barrier_post(unsigned* bar, volatile LAS unsigned* st) {
    XcdBarrier b; b.bar = bar; b.x = xb_xcc_id(); b.st = st;
    if (threadIdx.x == 0) (void)xb_add(&bar[XB_XCNT(b.x)], 1u);
    return b;
}
DI void xcd_barrier_complete(unsigned* bar, unsigned x, unsigned& nloc, unsigned& nx) {
    const unsigned G = gridDim.x * gridDim.y * gridDim.z;
    unsigned sum, cnt, mine, sp = 0u;
    for (;;) {
        sum = 0u; cnt = 0u; mine = 0u;
#pragma unroll
        for (unsigned j = 0; j < 16; ++j) { const unsigned c = xb_ld(&bar[XB_XCNT(j)]); sum += c; cnt += (c > 0u) ? 1u : 0u; mine = (j == x) ? c : mine; }
        if (sum == G) break;
        __builtin_amdgcn_s_sleep(1);
        if ((++sp & 255u) == 0u) { if (xb_ld(&bar[XB_TMO])) break; if (sp > XB_SPIN_CAP) { atomicAdd(&bar[XB_TMO], 1u); break; } }
    }
    nloc = mine > 0u ? mine : 1u; nx = cnt > 0u ? cnt : 1u;
}
DI void xcd_barrier(const XcdBarrier& b) {
    asm volatile("s_waitcnt vmcnt(0)" ::: "memory");
    __syncthreads();
    if (threadIdx.x == 0) {
        unsigned* bar = b.bar;
        __builtin_amdgcn_s_waitcnt(0);
        unsigned nloc = b.st[0], nx = b.st[1];
        if (nloc == 0u) { xcd_barrier_complete(bar, b.x, nloc, nx); b.st[0] = nloc; b.st[1] = nx; }
        const unsigned old = xb_add(&bar[XB_XSUB(b.x)], 1u);
        const unsigned gen = old / nloc;
        if (old + 1u == (gen + 1u) * nloc) {
            __builtin_amdgcn_fence(__ATOMIC_RELEASE, "agent");
            asm volatile("s_waitcnt vmcnt(0)" ::: "memory");
            const unsigned og = xb_add(&bar[XB_TOP], 1u);
            const unsigned tg = og / nx;
            if (og + 1u == (tg + 1u) * nx) xb_add(&bar[XB_TOPGEN], 1u);
            else XB_SPIN(xb_ld(&bar[XB_TOPGEN]) == tg, bar);
            __builtin_amdgcn_fence(__ATOMIC_ACQUIRE, "agent");
            xb_add(&bar[XB_XGEN(b.x)], 1u);
            asm volatile("s_waitcnt vmcnt(0)" ::: "memory");
        } else {
            XB_SPIN(xb_ld(&bar[XB_XGEN(b.x)]) == gen, bar);
            __builtin_amdgcn_fence(__ATOMIC_ACQUIRE, "agent");
            asm volatile("s_waitcnt vmcnt(0)" ::: "memory");
        }
    }
    __syncthreads();
}
struct GridBar { XcdBarrier b; DI void sync() const { xcd_barrier(b); } };
constexpr size_t OFF_BAR = 254 * MiB;
struct Params { const float* in[34]; float* out; char* ws; };

typedef __bf16 bf16x2_t __attribute__((ext_vector_type(2)));
typedef float f32x2_t __attribute__((ext_vector_type(2)));
DI u16 f2bf(float x) { return __builtin_bit_cast(u16, (__bf16)x); }
DI float bf2f(u16 b) { return __uint_as_float(((unsigned)b) << 16); }
DI unsigned pk2(float a, float b) { f32x2_t v = {a, b}; return __builtin_bit_cast(unsigned, __builtin_convertvector(v, bf16x2_t)); }
DI float blo(unsigned u) { return __uint_as_float(u << 16); }
DI float bhi(unsigned u) { return __uint_as_float(u & 0xffff0000u); }
template <class V4> DI void unpack8(const V4& v, float* f) {
  f[0] = blo(v.x); f[1] = bhi(v.x); f[2] = blo(v.y); f[3] = bhi(v.y); f[4] = blo(v.z); f[5] = bhi(v.z); f[6] = blo(v.w); f[7] = bhi(v.w);
}
DI uint4 pack8(const float* f) { uint4 v; v.x = pk2(f[0], f[1]); v.y = pk2(f[2], f[3]); v.z = pk2(f[4], f[5]); v.w = pk2(f[6], f[7]); return v; }
DI int crow(int r, int hh) { return (r & 3) + 8 * (r >> 2) + 4 * hh; }
DI float sigmoidf_(float x) { return __builtin_amdgcn_rcpf(1.f + __expf(-x)); }
DI float siluf_(float x) { return x * __builtin_amdgcn_rcpf(1.f + __expf(-x)); }
DI float softplusf_(float x) { return x > 20.f ? x : __logf(1.f + __expf(x)); }
template <int CTRL> DI float dppf(float v) { return __builtin_bit_cast(float, __builtin_amdgcn_update_dpp(0, __builtin_bit_cast(int, v), CTRL, 0xf, 0xf, true)); }
DI float row16_sum(float v) { v += dppf<0xB1>(v); v += dppf<0x4E>(v); v += dppf<0x141>(v); v += dppf<0x140>(v); return v; }
DI bf16x8 pack_frag(const f32x16& x, int s) {
  uint4 p;
  p.x = pk2(x[8 * s + 0], x[8 * s + 1]); p.y = pk2(x[8 * s + 2], x[8 * s + 3]);
  p.z = pk2(x[8 * s + 4], x[8 * s + 5]); p.w = pk2(x[8 * s + 6], x[8 * s + 7]);
  return __builtin_bit_cast(bf16x8, p);
}
DI bf16x8 ld_frag16(const u16* p) { return __builtin_bit_cast(bf16x8, *(const uint4*)p); }
DI bf16x8 ld_frag8x2(const u16* p) { uint2 a = *(const uint2*)p; uint2 b = *(const uint2*)(p + 8); uint4 v; v.x = a.x; v.y = a.y; v.z = b.x; v.w = b.y; return __builtin_bit_cast(bf16x8, v); }

template <int WM, int WN, class Epi>
DI void gemm_tile(const u16* __restrict__ A, int lda, const u16* __restrict__ A2, int lda2, int ksplit,
                  const u16* __restrict__ Bt, int ldb, int K, int m0, int n0, u16* smem, Epi&& epi) {
  constexpr int BM = 64 * WM, BN = 64 * WN, LD = 72;
  constexpr int NA = BM * 8 / 256, NBL = BN * 8 / 256;
  u16* sA = smem; u16* sB = smem + BM * LD;
  const int tid = threadIdx.x, lane = tid & 63, wave = tid >> 6, wm = wave >> 1, wn = wave & 1;
  u32x4 ra[NA], rb[NBL];
  f32x16 acc[WM][WN];
#pragma unroll
  for (int i = 0; i < WM; ++i)
#pragma unroll
    for (int j = 0; j < WN; ++j)
#pragma unroll
      for (int r = 0; r < 16; ++r) acc[i][j][r] = 0.f;
#define GLOAD(k0_) { const u16* Ap; int ld, kk; \
    if ((k0_) < ksplit) { Ap = A; ld = lda; kk = (k0_); } else { Ap = A2; ld = lda2; kk = (k0_) - ksplit; } \
    _Pragma("unroll") for (int i = 0; i < NA; ++i) { int c = tid + 256 * i; int row = c >> 3, col = (c & 7) * 8; ra[i] = *(const u32x4*)(Ap + (size_t)(m0 + row) * ld + kk + col); } \
    _Pragma("unroll") for (int i = 0; i < NBL; ++i) { int c = tid + 256 * i; int row = c >> 3, col = (c & 7) * 8; rb[i] = *(const u32x4*)(Bt + (size_t)(n0 + row) * ldb + (k0_) + col); } }
#define SSTORE() { \
    _Pragma("unroll") for (int i = 0; i < NA; ++i) { int c = tid + 256 * i; int row = c >> 3, col = (c & 7) * 8; *(u32x4*)(sA + row * LD + col) = ra[i]; } \
    _Pragma("unroll") for (int i = 0; i < NBL; ++i) { int c = tid + 256 * i; int row = c >> 3, col = (c & 7) * 8; *(u32x4*)(sB + row * LD + col) = rb[i]; } }
  constexpr bool DB = (2 * (BM + BN) * LD * 2 <= 72 * 1024);
  constexpr int STAGE = (BM + BN) * LD;
  const int lr = lane & 31, hh = lane >> 5;
  GLOAD(0);
  __syncthreads();
  SSTORE();
  __syncthreads();
  int buf = 0;
  for (int k0 = 0; k0 < K; k0 += 64) {
    const bool more = (k0 + 64 < K);
    if (more) GLOAD(k0 + 64);
    if constexpr (DB) __builtin_amdgcn_sched_barrier(0);
    __builtin_amdgcn_s_setprio(1);
    {
      const u16* cA = smem + (DB ? buf * STAGE : 0);
      const u16* cB = cA + BM * LD;
      if constexpr (DB) {
        bf16x8 af[2][WM], bfr[2][WN];
#pragma unroll
        for (int i = 0; i < WM; ++i) af[0][i] = *(const bf16x8*)(cA + (wm * 32 * WM + i * 32 + lr) * LD + hh * 8);
#pragma unroll
        for (int j = 0; j < WN; ++j) bfr[0][j] = *(const bf16x8*)(cB + (wn * 32 * WN + j * 32 + lr) * LD + hh * 8);
#pragma unroll
        for (int ks = 0; ks < 4; ++ks) {
          if (ks + 1 < 4) {
#pragma unroll
            for (int i = 0; i < WM; ++i) af[(ks + 1) & 1][i] = *(const bf16x8*)(cA + (wm * 32 * WM + i * 32 + lr) * LD + (ks + 1) * 16 + hh * 8);
#pragma unroll
            for (int j = 0; j < WN; ++j) bfr[(ks + 1) & 1][j] = *(const bf16x8*)(cB + (wn * 32 * WN + j * 32 + lr) * LD + (ks + 1) * 16 + hh * 8);
          }
#pragma unroll
          for (int i = 0; i < WM; ++i)
#pragma unroll
            for (int j = 0; j < WN; ++j) acc[i][j] = MFMA(af[ks & 1][i], bfr[ks & 1][j], acc[i][j]);
        }
      } else {
#pragma unroll
        for (int ks = 0; ks < 4; ++ks) {
          bf16x8 af[WM], bfr[WN];
#pragma unroll
          for (int i = 0; i < WM; ++i) af[i] = *(const bf16x8*)(cA + (wm * 32 * WM + i * 32 + lr) * LD + ks * 16 + hh * 8);
#pragma unroll
          for (int j = 0; j < WN; ++j) bfr[j] = *(const bf16x8*)(cB + (wn * 32 * WN + j * 32 + lr) * LD + ks * 16 + hh * 8);
#pragma unroll
          for (int i = 0; i < WM; ++i)
#pragma unroll
            for (int j = 0; j < WN; ++j) acc[i][j] = MFMA(af[i], bfr[j], acc[i][j]);
        }
      }
    }
    __builtin_amdgcn_s_setprio(0);
    if constexpr (DB) __builtin_amdgcn_sched_barrier(0);
    if (DB) {
      if (more) {
        u16* sA = smem + (buf ^ 1) * STAGE; u16* sB = sA + BM * LD;
        SSTORE();
      }
      __syncthreads();
      buf ^= 1;
    } else {
      __syncthreads();
      if (more) SSTORE();
      __syncthreads();
    }
  }
  epi(m0 + wm * 32 * WM, n0 + wn * 32 * WN, acc);
}

DI void conv_weight(const float* __restrict__ W, int K, int N, int Npad, u16* __restrict__ Wt, int mode, float* sT, int bid, int nb) {
  const int tid = threadIdx.x;
  const int ktn = K / 64, ntn = Npad / 128;
  for (int t = bid; t < ktn * ntn; t += nb) {
    const int kt = t / ntn, nt = t % ntn;
    float4 wv[8];
#pragma unroll
    for (int i = 0; i < 8; ++i) {
      int e = tid + 256 * i; int kk = e >> 5, nn = (e & 31) * 4; int n = nt * 128 + nn;
      wv[i] = (n < N) ? *(const float4*)(W + (size_t)(kt * 64 + kk) * N + n) : make_float4(0.f, 0.f, 0.f, 0.f);
    }
    __syncthreads();
#pragma unroll
    for (int i = 0; i < 8; ++i) {
      int e = tid + 256 * i; int kk = e >> 5, nn = (e & 31) * 4;
      sT[kk * 129 + nn] = wv[i].x; sT[kk * 129 + nn + 1] = wv[i].y; sT[kk * 129 + nn + 2] = wv[i].z; sT[kk * 129 + nn + 3] = wv[i].w;
    }
    __syncthreads();
#pragma unroll
    for (int i = 0; i < 4; ++i) {
      int c = tid + 256 * i; int nn = c >> 3, k8 = (c & 7) * 8;
      float f[8];
#pragma unroll
      for (int q = 0; q < 8; ++q) f[q] = sT[(k8 + q) * 129 + nn];
      int n = nt * 128 + nn, row = n;
      if (mode == 1) { int j = (n < FFN_H) ? n : n - FFN_H; row = (j >> 5) * 64 + (j & 31) + ((n < FFN_H) ? 0 : 32); }
      *(uint4*)(Wt + (size_t)row * K + kt * 64 + k8) = pack8(f);
    }
  }
}

DI void conv_act(const float* __restrict__ src, u16* __restrict__ dst, size_t n, int bid, int nb) {
  const size_t stride = (size_t)nb * 256 * 8;
  size_t i = ((size_t)bid * 256 + threadIdx.x) * 8;
  for (; i + 3 * stride < n; i += 4 * stride) {
    float4 a[4], b[4];
#pragma unroll
    for (int u = 0; u < 4; ++u) { a[u] = *(const float4*)(src + i + u * stride); b[u] = *(const float4*)(src + i + u * stride + 4); }
#pragma unroll
    for (int u = 0; u < 4; ++u) {
      float f[8] = {a[u].x, a[u].y, a[u].z, a[u].w, b[u].x, b[u].y, b[u].z, b[u].w};
      *(uint4*)(dst + i + u * stride) = pack8(f);
    }
  }
  for (; i < n; i += stride) {
    float4 a = *(const float4*)(src + i), b = *(const float4*)(src + i + 4);
    float f[8] = {a.x, a.y, a.z, a.w, b.x, b.y, b.z, b.w};
    *(uint4*)(dst + i) = pack8(f);
  }
}

DI void ln_phase(float* __restrict__ X, const float* __restrict__ g, const float* __restrict__ bta, u16* __restrict__ XB, int bid, int nb) {
  const int lane = threadIdx.x & 63, wave = threadIdx.x >> 6;
  for (int row = bid * 4 + wave; row < M_; row += nb * 4) {
    float* xr = X + (size_t)row * 1024;
    float4 v[4];
    float s = 0.f;
#pragma unroll
    for (int i = 0; i < 4; ++i) { v[i] = *(const float4*)(xr + 4 * lane + 256 * i); s += v[i].x + v[i].y + v[i].z + v[i].w; }
#pragma unroll
    for (int o = 32; o > 0; o >>= 1) s += __shfl_xor(s, o);
    const float mu = s * (1.f / 1024.f);
    float q = 0.f;
#pragma unroll
    for (int i = 0; i < 4; ++i) { float a = v[i].x - mu, b = v[i].y - mu, c = v[i].z - mu, d = v[i].w - mu; q += a * a + b * b + c * c + d * d; }
#pragma unroll
    for (int o = 32; o > 0; o >>= 1) q += __shfl_xor(q, o);
    const float rs = rsqrtf(q * (1.f / 1024.f) + 1e-5f);
#pragma unroll
    for (int i = 0; i < 4; ++i) {
      const int c = 4 * lane + 256 * i;
      float4 gg = *(const float4*)(g + c), bb = *(const float4*)(bta + c), o;
      o.x = (v[i].x - mu) * rs * gg.x + bb.x; o.y = (v[i].y - mu) * rs * gg.y + bb.y;
      o.z = (v[i].z - mu) * rs * gg.z + bb.z; o.w = (v[i].w - mu) * rs * gg.w + bb.w;
      *(float4*)(xr + c) = o;
      uint2 pb; pb.x = pk2(o.x, o.y); pb.y = pk2(o.z, o.w);
      *(uint2*)(XB + (size_t)row * 1024 + c) = pb;
    }
  }
}

DI void block_cumsum128(float* s) {
  const int tid = threadIdx.x, lane = tid & 63;
  __syncthreads();
  float v = (tid < 128) ? s[tid] : 0.f;
#pragma unroll
  for (int off = 1; off < 64; off <<= 1) { const float u = __shfl_up(v, off); if (lane >= off) v += u; }
  if (tid < 64) s[tid] = v;
  __syncthreads();
  if (tid >= 64 && tid < 128) s[tid] = v + s[63];
  __syncthreads();
}

struct EpiResid {
  const float* R; float* X;
  template <class ACC> DI void operator()(int mw, int nw, ACC& acc) const {
    const int lr = threadIdx.x & 31, hh = (threadIdx.x & 63) >> 5;
#pragma unroll
    for (int i = 0; i < 2; ++i)
#pragma unroll
      for (int j = 0; j < 2; ++j)
#pragma unroll
        for (int r = 0; r < 16; ++r) {
          size_t idx = (size_t)(mw + 32 * i + crow(r, hh)) * 1024 + nw + 32 * j + lr;
          X[idx] = ALPHA * R[idx] + acc[i][j][r];
        }
  }
};
template <int TRANS, class F>
DI void stage_tile(f32x16 (&acc)[2][2], u16* sT, F&& f) {
  const int tid = threadIdx.x, lane = tid & 63, wave = tid >> 6, wm = wave >> 1, wn = wave & 1, lr = lane & 31, hh = lane >> 5;
#pragma unroll
  for (int i = 0; i < 2; ++i)
#pragma unroll
    for (int j = 0; j < 2; ++j)
#pragma unroll
      for (int r = 0; r < 16; ++r) {
        const int row = wm * 64 + 32 * i + crow(r, hh), col = wn * 64 + 32 * j + lr;
        sT[TRANS ? col * 136 + row : row * 136 + col] = f2bf(acc[i][j][r]);
      }
  __syncthreads();
#pragma unroll
  for (int q = 0; q < 8; ++q) {
    const int c = tid + 256 * q; const int rr = c >> 4, cc = (c & 15) * 8;
    f(rr, cc, *(const u32x4*)(sT + rr * 136 + cc));
  }
}
struct EpiBf16 {
  u16* C; int ldc; u16* sT;
  template <class ACC> DI void operator()(int mw, int nw, ACC& acc) const {
    const int wave = threadIdx.x >> 6;
    const int m0 = mw - (wave >> 1) * 64, n0 = nw - (wave & 1) * 64;
    u16* Cp = C; const int ld = ldc;
    stage_tile<0>(acc, sT, [&](int rr, int cc, const u32x4& v) __attribute__((always_inline)) { *(u32x4*)(Cp + (size_t)(m0 + rr) * ld + n0 + cc) = v; });
  }
};

template <class Epi>
DI void gemm_phase22(const u16* A, int lda, const u16* A2, int lda2, int ksplit, const u16* Bt, int ldb, int K, int Mrows, int Ncols,
                     u16* smem, Epi&& epi, int bid, int nb) {
  const int ntn = Ncols / 128, ntm = Mrows / 128;
  if ((ntm & 63) == 0 && (nb & 7) == 0) {
    const int xcd = bid & 7, local = bid >> 3, nlocal = nb >> 3, mper = ntm >> 3;
    for (int idx = local; idx < mper * ntn; idx += nlocal) {
      const int sm = idx / (8 * ntn), rem = idx - sm * 8 * ntn, tn = rem >> 3, tmi = rem & 7;
      gemm_tile<2, 2>(A, lda, A2, lda2, ksplit, Bt, ldb, K, (xcd * mper + sm * 8 + tmi) * 128, tn * 128, smem, epi);
    }
  } else {
    for (int t = bid; t < ntm * ntn; t += nb) gemm_tile<2, 2>(A, lda, A2, lda2, ksplit, Bt, ldb, K, (t / ntn) * 128, (t % ntn) * 128, smem, epi);
  }
}

DI void xattn_ffn(const Params& p, int layer, const GridBar& grid, u16* smem, int bid, int nb, bool conv_mem_kv) {
  char* ws = p.ws;
  float* X = p.out;
  u16* XB = (u16*)(ws + OFF_XB);
  const char* lw = ws + OFF_LW + LW_STRIDE * layer;
  const u16* WQ = (const u16*)(lw + LW_WQ); const u16* WKV = (const u16*)(lw + LW_WKV); const u16* WO = (const u16*)(lw + LW_WO);
  const u16* W13 = (const u16*)(lw + LW_W13); const u16* W2F = (const u16*)(lw + LW_W2F);
  u16* Q = (u16*)(ws + OFF_S0); u16* Pm = (u16*)(ws + OFF_S1); u16* O = (u16*)(ws + OFF_S2); u16* H = (u16*)(ws + OFF_S0);
  u16* XAK = (u16*)(ws + OFF_XAK) + (size_t)layer * 1024 * 1024;
  u16* XAVT = (u16*)(ws + OFF_XAVT) + (size_t)layer * 1024 * 1024;
  const u16* MEMB = (const u16*)(ws + OFF_MEMB);
  const int tid = threadIdx.x, lane = tid & 63, lr = lane & 31, hh = lane >> 5;
  gemm_phase22(XB, 1024, XB, 1024, 1024, WQ, 1024, 1024, M_, 1024, smem, EpiBf16{Q, 1024, smem}, bid, nb);
  {
    auto epi = [&](int mw, int nw, f32x16 (&acc)[2][2]) __attribute__((always_inline)) {
      const int wv = tid >> 6;
      const int m0 = mw - (wv >> 1) * 64, n0 = nw - (wv & 1) * 64;
      if (n0 < 1024) {
        stage_tile<0>(acc, smem, [&](int rr, int cc, const u32x4& v) __attribute__((always_inline)) { *(u32x4*)(XAK + (size_t)(m0 + rr) * 1024 + n0 + cc) = v; });
      } else {
        stage_tile<1>(acc, smem, [&](int rr, int cc, const u32x4& v) __attribute__((always_inline)) {
          const int c = n0 - 1024 + rr, m = m0 + cc;
          *(u32x4*)(XAVT + ((size_t)((m >> 8) * 1024 + c)) * 256 + (m & 255)) = v;
        });
      }
    };
    gemm_phase22(MEMB, 1024, MEMB, 1024, 1024, WKV, 1024, 1024, 1024, 2048, smem, epi, (bid + nb / 2) % nb, nb);
  }
  grid.sync();
  {
    float* sred = (float*)(smem + 35840);
    u16* sP = smem;
    u16* sV = smem + 17408;
    for (int t = bid; t < 16 * 64; t += nb) {
      const int tid = FRESH_TID(), lane = tid & 63, lr = lane & 31, hh = lane >> 5, wave = tid >> 6, wm = wave >> 1, wn = wave & 1;
      const int bh = t >> 6, tm = t & 63, b = bh >> 2, h = bh & 3;
      const u16* Ab = Q + (size_t)b * 4096 * 1024 + h * 256;
      const u16* Bb = XAK + (size_t)b * 256 * 1024 + h * 256;
      const u16* Vb = XAVT + (size_t)bh * 256 * 256;
      u16* Ob = O + (size_t)b * 4096 * 1024 + h * 256;
      auto epi = [&](int mw, int nw, f32x16 (&acc)[1][4]) __attribute__((always_inline)) {
        float mx[16];
#pragma unroll
        for (int r = 0; r < 16; ++r) {
          float v = -1e30f;
#pragma unroll
          for (int j = 0; j < 4; ++j) { acc[0][j][r] *= 0.0625f; v = fmaxf(v, acc[0][j][r]); }
#pragma unroll
          for (int o = 16; o > 0; o >>= 1) v = fmaxf(v, __shfl_xor(v, o));
          mx[r] = v;
        }
        const int rbase = mw - tm * 64;
        if (lr == 0) {
#pragma unroll
          for (int r = 0; r < 16; ++r) sred[wn * 64 + rbase + crow(r, hh)] = mx[r];
        }
        __syncthreads();
        float sm[16];
#pragma unroll
        for (int r = 0; r < 16; ++r) {
          const int row = rbase + crow(r, hh);
          const float m2 = fmaxf(sred[row], sred[64 + row]);
          float s = 0.f;
#pragma unroll
          for (int j = 0; j < 4; ++j) { float e = __expf(acc[0][j][r] - m2); acc[0][j][r] = e; s += e; }
#pragma unroll
          for (int o = 16; o > 0; o >>= 1) s += __shfl_xor(s, o);
          sm[r] = s;
        }
        if (lr == 0) {
#pragma unroll
          for (int r = 0; r < 16; ++r) sred[128 + wn * 64 + rbase + crow(r, hh)] = sm[r];
        }
        __syncthreads();
#pragma unroll
        for (int r = 0; r < 16; ++r) {
          const int row = rbase + crow(r, hh);
          const float inv = __builtin_amdgcn_rcpf(sred[128 + row] + sred[192 + row]);
#pragma unroll
          for (int j = 0; j < 4; ++j) sP[row * 264 + nw + 32 * j + lr] = f2bf(acc[0][j][r] * inv);
        }
        __builtin_amdgcn_sched_barrier(0);
        u32x4 vr[8];
#pragma unroll
        for (int i = 0; i < 8; ++i) { const int c = tid + 256 * i; vr[i] = *(const u32x4*)(Vb + (size_t)(c >> 3) * 256 + (c & 7) * 8); }
        f32x16 o2[4];
#pragma unroll
        for (int j = 0; j < 4; ++j)
#pragma unroll
          for (int r = 0; r < 16; ++r) o2[j][r] = 0.f;
#pragma unroll 1
        for (int kt = 0; kt < 4; ++kt) {
          __syncthreads();
#pragma unroll
          for (int i = 0; i < 8; ++i) { const int c = tid + 256 * i; *(u32x4*)(sV + (c >> 3) * 72 + (c & 7) * 8) = vr[i]; }
          if (kt + 1 < 4) {
#pragma unroll
            for (int i = 0; i < 8; ++i) { const int c = tid + 256 * i; vr[i] = *(const u32x4*)(Vb + (size_t)(c >> 3) * 256 + (kt + 1) * 64 + (c & 7) * 8); }
          }
          __syncthreads();
#pragma unroll
          for (int ks = 0; ks < 4; ++ks) {
            const bf16x8 af = *(const bf16x8*)(sP + (wm * 32 + lr) * 264 + kt * 64 + ks * 16 + hh * 8);
#pragma unroll
            for (int j = 0; j < 4; ++j) {
              const bf16x8 bfr = *(const bf16x8*)(sV + (wn * 128 + 32 * j + lr) * 72 + ks * 16 + hh * 8);
              o2[j] = MFMA(af, bfr, o2[j]);
            }
          }
        }
        __syncthreads();
#pragma unroll
        for (int j = 0; j < 4; ++j)
#pragma unroll
          for (int r = 0; r < 16; ++r) sP[(rbase + crow(r, hh)) * 264 + wn * 128 + 32 * j + lr] = f2bf(o2[j][r]);
        __syncthreads();
#pragma unroll
        for (int q = 0; q < 8; ++q) {
          const int c = tid + 256 * q; const int rr = c >> 5, cc = (c & 31) * 8;
          *(u32x4*)(Ob + (size_t)(tm * 64 + rr) * 1024 + cc) = *(const u32x4*)(sP + rr * 264 + cc);
        }
      };
      gemm_tile<1, 4>(Ab, 1024, Ab, 1024, 256, Bb, 1024, 256, tm * 64, 0, smem, epi);
    }
  }
  grid.sync();
  gemm_phase22(O, 1024, O, 1024, 1024, WO, 1024, 1024, M_, 1024, smem, EpiResid{X, X}, bid, nb);
  grid.sync();
  ln_phase(X, p.in[28] + layer * 1024, p.in[29] + layer * 1024, XB, bid, nb);
  grid.sync();
  {
    auto epi = [&](int mw, int nw, f32x16 (&acc)[2][2]) __attribute__((always_inline)) {
      const int wv = tid >> 6, wm_ = wv >> 1, wn_ = wv & 1;
      const int m0 = mw - wm_ * 64, n0 = nw - wn_ * 64;
      u16* sT = smem;
#pragma unroll
      for (int i = 0; i < 2; ++i)
#pragma unroll
        for (int r = 0; r < 16; ++r) {
          const float g = acc[i][0][r], u = acc[i][1][r];
          sT[(wm_ * 64 + 32 * i + crow(r, hh)) * 72 + wn_ * 32 + lr] = f2bf(siluf_(g) * u);
        }
      __syncthreads();
#pragma unroll
      for (int q = 0; q < 4; ++q) {
        const int c = tid + 256 * q; const int rr = c >> 3, cc = (c & 7) * 8;
        *(u32x4*)(H + (size_t)(m0 + rr) * FFN_H + (n0 >> 1) + cc) = *(const u32x4*)(sT + rr * 72 + cc);
      }
    };
    for (int rpt = 0; rpt < RPT_FFN; ++rpt)
    gemm_phase22(XB, 1024, XB, 1024, 1024, W13, 1024, 1024, M_, 2 * FFN_H, smem, epi, bid, nb);
  }
  grid.sync();
  gemm_phase22(H, FFN_H, H, FFN_H, FFN_H, W2F, FFN_H, FFN_H, M_, 1024, smem, EpiResid{X, X}, bid, nb);
  grid.sync();
  ln_phase(X, p.in[32] + layer * 1024, p.in[33] + layer * 1024, XB, bid, nb);
  if (layer == 0) grid.sync();
}

__global__ void __launch_bounds__(256, 2) fwd_megakernel(Params p) {
  __shared__ __attribute__((aligned(16))) char smem_raw[72 * 1024];
  __shared__ uint4 xb_words;
  if (p.ws == nullptr) cg::this_grid().sync();
  if (threadIdx.x == 0) xb_words = make_uint4(0u, 0u, 0u, 0u);
  __syncthreads();
  GridBar grid;
  grid.b = xcd_barrier_post((unsigned*)(p.ws + OFF_BAR), (volatile LAS unsigned*)&xb_words);
  u16* smem = (u16*)smem_raw;
  float* smf = (float*)smem_raw;
  const int bid = blockIdx.x, nb = gridDim.x, tid = threadIdx.x, lane = tid & 63, wave = tid >> 6, lr = lane & 31, hh = lane >> 5;
  char* ws = p.ws;
  char* dout = (char*)p.out;
  u16* RW = (u16*)(ws + OFF_RW); u16* XBC = (u16*)(ws + OFF_XBC); u16* Z = (u16*)(ws + OFF_Z);
  u16* WIN = (u16*)(ws + OFF_WIN); u16* WOUT = (u16*)(ws + OFF_WOUT); u16* XB = (u16*)(ws + OFF_XB);
  float* DT = (float*)(ws + OFF_DT); u16* LIN = (u16*)(ws + OFF_LIN); u16* MEMB = (u16*)(ws + OFF_MEMB);
  float* KMEAN = (float*)(ws + OFF_KMEAN); float* CDEC = (float*)(ws + OFF_CDEC);
  u16* W2T = (u16*)(ws + OFF_LORAW); u16* A2T = W2T + 1024 * 64; u16* G2T = A2T + 1024 * 64;
  u16* XT = (u16*)(dout + DO_XT); u16* BM = (u16*)(dout + DO_BM); u16* BMT = (u16*)(dout + DO_BMT); u16* CM = (u16*)(dout + DO_CM);
  u16* WE = (u16*)(dout + DO_WE); u16* AA = (u16*)(dout + DO_AA);
  u16* STATES = (u16*)(ws + OFF_STATES); u16* GG = (u16*)(ws + OFF_GG); u16* YR = (u16*)(ws + OFF_YR);

  conv_weight(p.in[2], 1024, EVEN_IN, EVEN_IN_PAD, WIN, 0, smf, bid, nb);
  conv_weight(p.in[20], 2048, 1024, 1024, WOUT, 0, smf, bid, nb);
  conv_weight(p.in[11], 64, 1024, 1024, W2T, 0, smf, bid, nb);
  conv_weight(p.in[13], 64, 1024, 1024, A2T, 0, smf, bid, nb);
  conv_weight(p.in[14], 128, 1024, 1024, G2T, 0, smf, bid, nb);
  conv_act(p.in[0], XB, (size_t)M_ * 1024, bid, nb);
  conv_act(p.in[1], MEMB, (size_t)1024 * 1024, bid, nb);
  grid.sync();

  {
    const float* dtb = p.in[5];
    auto epi = [&](int mw, int nw, f32x16 (&acc)[2][2]) __attribute__((always_inline)) {
      const int wv = tid >> 6;
      const int m0 = mw - (wv >> 1) * 64, n0 = nw - (wv & 1) * 64;
      if (nw == 2560 && lr < 16) {
#pragma unroll
        for (int i = 0; i < 2; ++i)
#pragma unroll
          for (int r = 0; r < 16; ++r) DT[(size_t)(mw + 32 * i + crow(r, hh)) * 16 + lr] = softplusf_(acc[i][0][r] + dtb[lr]);
      }
      stage_tile<0>(acc, smem, [&](int rr, int cc, const u32x4& v) __attribute__((always_inline)) {
        const int n = n0 + cc; const size_t m = m0 + rr;
        if (n < 1024) *(u32x4*)(Z + m * 1024 + n) = v;
        else if (n < 2560) *(u32x4*)(XBC + m * 1536 + (n - 1024)) = v;
        else if (n < 2576) { }
        else if (n < EVEN_IN) *(u32x4*)(RW + m * 3328 + (n - 2576)) = v;
      });
    };
    gemm_phase22(XB, 1024, XB, 1024, 1024, WIN, 1024, 1024, M_, EVEN_IN_PAD, smem, epi, bid, nb);
  }
  grid.sync();

  {
    const float* cw = p.in[3]; const float* cb = p.in[4];
    u16* sT = smem;
    for (int t = bid; t < 256 * 24; t += nb) {
      const int tt = t / 24, ct = t % 24;
      const int tok = tid >> 2, cq = tid & 3;
      const int gt = tt * 64 + tok, s = gt & 4095;
      const int c0 = ct * 64 + cq * 16;
      float accv[16];
#pragma unroll
      for (int q = 0; q < 16; ++q) accv[q] = cb[c0 + q];
      u32x4 xv[4][2];
#pragma unroll
      for (int k = 0; k < 4; ++k) {
        const int kk = (s - 3 + k >= 0) ? k : 3;
        const u16* src = XBC + (size_t)(gt - 3 + kk) * 1536 + c0;
        xv[k][0] = *(const u32x4*)src; xv[k][1] = *(const u32x4*)(src + 8);
      }
#pragma unroll
      for (int k = 0; k < 4; ++k) {
        float f[16];
        unpack8(xv[k][0], f); unpack8(xv[k][1], f + 8);
        const float msk = (s - 3 + k >= 0) ? 1.f : 0.f;
#pragma unroll
        for (int q = 0; q < 16; ++q) accv[q] += cw[k * 1536 + c0 + q] * (f[q] * msk);
      }
#pragma unroll
      for (int q = 0; q < 16; ++q) accv[q] = siluf_(accv[q]);
      const bool transposed = (ct < 20);
      if (ct >= 16) {
        u16* dst = (ct < 20 ? BM : CM) + (size_t)gt * 256 + ((ct - 16) & 3) * 64 + cq * 16;
        *(uint4*)dst = pack8(accv); *(uint4*)(dst + 8) = pack8(accv + 8);
      }
      if (transposed) {
        __syncthreads();
#pragma unroll
        for (int q = 0; q < 16; ++q) sT[(cq * 16 + q) * 72 + tok] = f2bf(accv[q]);
        __syncthreads();
        const int ch = tid >> 2, tq = tid & 3;
        const int b = tt >> 6, s0 = (tt & 63) * 64;
        u16* dst;
        if (ct < 16) dst = XT + ((size_t)((b * 16 + ct) * 64 + ch)) * 4096 + s0 + tq * 16;
        else dst = BMT + ((size_t)(b * 256 + (ct - 16) * 64 + ch)) * 4096 + s0 + tq * 16;
        *(uint4*)dst = *(const uint4*)(sT + ch * 72 + tq * 16);
        *(uint4*)(dst + 8) = *(const uint4*)(sT + ch * 72 + tq * 16 + 8);
      }
    }
    const float* mu = p.in[9];
    for (int i = bid * 256 + tid; i < M_ * 32; i += nb * 256) {
      const int gt = i >> 5, c8 = (i & 31) * 8, s = gt & 4095;
      const u16* cur = RW + (size_t)gt * 3328 + 3072 + c8;
      float fc[8], fp[8];
      unpack8(*(const uint4*)cur, fc);
      if (s > 0) unpack8(*(const uint4*)(cur - 3328), fp);
      else {
#pragma unroll
        for (int q = 0; q < 8; ++q) fp[q] = 0.f;
      }
      float o[8];
#pragma unroll
      for (int q = 0; q < 8; ++q) {
        float v = fc[q] + (fp[q] - fc[q]) * mu[3072 + c8 + q];
        o[q] = (c8 < 64) ? tanhf(v) : ((c8 < 128) ? v : sigmoidf_(v));
      }
      *(uint4*)(LIN + (size_t)gt * 256 + c8) = pack8(o);
    }
  }
  grid.sync();

  {
    u16* sBt = smem;
    u16* sX = smem + 128 * 136;
    float* sac = (float*)(smem + 192 * 136);
    float* ssc = sac + 128;
    const float* alog = p.in[6];
    const int lrow = tid >> 4, lcol = (tid & 15) * 8;
    for (int t = bid; t < 512; t += nb) {
      const int b = t >> 7, c = (t >> 2) & 31, g = (t >> 1) & 1, half = t & 1;
      const int tok0 = b * 4096 + c * 128;
      u32x4 bt[8];
#pragma unroll
      for (int i = 0; i < 8; ++i) bt[i] = *(const u32x4*)(BMT + ((size_t)((b * 2 + g) * 128 + lrow + 16 * i)) * 4096 + c * 128 + lcol);
      __syncthreads();
#pragma unroll
      for (int i = 0; i < 8; ++i) *(u32x4*)(sBt + (lrow + 16 * i) * 136 + lcol) = bt[i];
      for (int hq = 0; hq < 4; ++hq) {
        const int h = g * 8 + half * 4 + hq;
        const int ti = (b * 32 + c) * 16 + h;
        const float aneg = -__expf(alog[h]);
        u32x4 xv[4];
#pragma unroll
        for (int i = 0; i < 4; ++i) xv[i] = *(const u32x4*)(XT + ((size_t)((b * 16 + h) * 64 + lrow + 16 * i)) * 4096 + c * 128 + lcol);
        float dtv = 0.f;
        if (tid < 128) dtv = DT[(size_t)(tok0 + tid) * 16 + h];
        __syncthreads();
        if (tid < 128) sac[tid] = dtv * aneg;
        block_cumsum128(sac);
        const float alast = sac[127];
        if (tid < 128) ssc[tid] = dtv * __expf(alast - sac[tid]);
        if (tid == 0) CDEC[ti] = __expf(alast);
        __syncthreads();
        {
          const float4 s0 = *(const float4*)(ssc + lcol), s1 = *(const float4*)(ssc + lcol + 4);
#pragma unroll
          for (int i = 0; i < 4; ++i) {
            float f[8];
            unpack8(xv[i], f);
            f[0] *= s0.x; f[1] *= s0.y; f[2] *= s0.z; f[3] *= s0.w; f[4] *= s1.x; f[5] *= s1.y; f[6] *= s1.z; f[7] *= s1.w;
            *(uint4*)(sX + (lrow + 16 * i) * 136 + lcol) = pack8(f);
          }
        }
        __syncthreads();
        f32x16 acc[2];
#pragma unroll
        for (int r = 0; r < 16; ++r) { acc[0][r] = 0.f; acc[1][r] = 0.f; }
#pragma unroll
        for (int ks = 0; ks < 8; ++ks) {
          const bf16x8 bf = *(const bf16x8*)(sBt + (32 * wave + lr) * 136 + 16 * ks + 8 * hh);
#pragma unroll
          for (int pt = 0; pt < 2; ++pt) {
            const bf16x8 af = *(const bf16x8*)(sX + (32 * pt + lr) * 136 + 16 * ks + 8 * hh);
            acc[pt] = MFMA(af, bf, acc[pt]);
          }
        }
        u16* dst = STATES + (size_t)ti * 8192;
#pragma unroll
        for (int pt = 0; pt < 2; ++pt)
#pragma unroll
          for (int r = 0; r < 16; ++r) dst[(32 * pt + crow(r, hh)) * 128 + 32 * wave + lr] = f2bf(acc[pt][r]);
      }
    }
  }
  grid.sync();

  for (int gt = bid * 256 + tid; gt < 65536; gt += nb * 256) {
    const int bhh = gt >> 10, e = (gt & 1023) * 8, b = bhh >> 4, h = bhh & 15;
    float carry[8];
#pragma unroll
    for (int q = 0; q < 8; ++q) carry[q] = 0.f;
    for (int cb8 = 0; cb8 < 32; cb8 += 8) {
      u32x4 sv8[8]; float dec8[8];
#pragma unroll
      for (int i = 0; i < 8; ++i) {
        const int ti = (b * 32 + cb8 + i) * 16 + h;
        sv8[i] = *(const u32x4*)(STATES + (size_t)ti * 8192 + e);
        dec8[i] = CDEC[ti];
      }
#pragma unroll
      for (int i = 0; i < 8; ++i) {
        const int ti = (b * 32 + cb8 + i) * 16 + h;
        float st[8];
        unpack8(sv8[i], st);
        *(uint4*)(STATES + (size_t)ti * 8192 + e) = pack8(carry);
#pragma unroll
        for (int q = 0; q < 8; ++q) carry[q] = carry[q] * dec8[i] + st[q];
      }
    }
  }
  grid.sync();

  {
    u16* sB = smem;
    u16* sC = smem + 128 * 136;
    u16* sX = smem + 128 * 136;
    u16* sS = smem + 192 * 136;
    float* sac = (float*)(smem + 256 * 136);
    float* sdt = sac + 128;
    const float* alog = p.in[6]; const float* dsk = p.in[7];
    const int lrow = tid >> 4, lcol = (tid & 15) * 8;
    const int w = wave, l = 32 * w + lr;
    for (int t = bid; t < 512; t += nb) {
      const int b = t >> 7, c = (t >> 2) & 31, g = (t >> 1) & 1, half = t & 1;
      const int tok0 = b * 4096 + c * 128;
      {
        u32x4 bv[8], cv[8];
#pragma unroll
        for (int i = 0; i < 8; ++i) {
          bv[i] = *(const u32x4*)(BM + (size_t)(tok0 + lrow + 16 * i) * 256 + g * 128 + lcol);
          cv[i] = *(const u32x4*)(CM + (size_t)(tok0 + lrow + 16 * i) * 256 + g * 128 + lcol);
        }
        __syncthreads();
#pragma unroll
        for (int i = 0; i < 8; ++i) {
          *(u32x4*)(sB + (lrow + 16 * i) * 136 + lcol) = bv[i];
          *(u32x4*)(sC + (lrow + 16 * i) * 136 + lcol) = cv[i];
        }
        __syncthreads();
      }
      bf16x8 qf[8];
#pragma unroll
      for (int ks = 0; ks < 8; ++ks) qf[ks] = *(const bf16x8*)(sC + l * 136 + 16 * ks + 8 * hh);
#pragma unroll 1
      for (int hq = 0; hq < 4; ++hq) {
        const int h = g * 8 + half * 4 + hq;
        const int ti = (b * 32 + c) * 16 + h;
        const float aneg = -__expf(alog[h]);
        const float dskip = dsk[h];
        u32x4 xv[4], sv[4];
#pragma unroll
        for (int i = 0; i < 4; ++i) {
          xv[i] = *(const u32x4*)(XT + ((size_t)((b * 16 + h) * 64 + lrow + 16 * i)) * 4096 + c * 128 + lcol);
          sv[i] = *(const u32x4*)(STATES + (size_t)ti * 8192 + (lrow + 16 * i) * 128 + lcol);
        }
        float dtv = 0.f;
        if (tid < 128) dtv = DT[(size_t)(tok0 + tid) * 16 + h];
        __syncthreads();
#pragma unroll
        for (int i = 0; i < 4; ++i) {
          *(u32x4*)(sX + (lrow + 16 * i) * 136 + lcol) = xv[i];
          *(u32x4*)(sS + (lrow + 16 * i) * 136 + lcol) = sv[i];
        }
        if (tid < 128) { sdt[tid] = dtv; sac[tid] = dtv * aneg; }
        block_cumsum128(sac);
        const float al = sac[l];
        const float eal = __expf(al);
        uint2 zv[2][4];
#pragma unroll
        for (int pt = 0; pt < 2; ++pt)
#pragma unroll
          for (int q4 = 0; q4 < 4; ++q4) zv[pt][q4] = *(const uint2*)(Z + (size_t)(tok0 + l) * 1024 + h * 64 + 32 * pt + 8 * q4 + 4 * hh);
        f32x16 O[2];
#pragma unroll
        for (int r = 0; r < 16; ++r) { O[0][r] = 0.f; O[1][r] = 0.f; }
#pragma unroll
        for (int ks = 0; ks < 8; ++ks)
#pragma unroll
          for (int pt = 0; pt < 2; ++pt) O[pt] = MFMA(*(const bf16x8*)(sS + (32 * pt + lr) * 136 + 16 * ks + 8 * hh), qf[ks], O[pt]);
#pragma unroll
        for (int r = 0; r < 16; ++r) { O[0][r] *= eal; O[1][r] *= eal; }
#pragma unroll 1
        for (int st = 0; st < 4; ++st) {
          if (st <= w) {
            f32x16 Sx;
#pragma unroll
            for (int r = 0; r < 16; ++r) Sx[r] = 0.f;
#pragma unroll
            for (int ks = 0; ks < 8; ++ks) Sx = MFMA(*(const bf16x8*)(sB + (32 * st + lr) * 136 + 16 * ks + 8 * hh), qf[ks], Sx);
#pragma unroll
            for (int r = 0; r < 16; ++r) {
              const int s = 32 * st + crow(r, hh);
              float v = (s <= l) ? Sx[r] * __expf(al - sac[s]) * sdt[s] : 0.f;
              if (s == l) v += dskip;
              Sx[r] = v;
            }
#pragma unroll
            for (int s2 = 0; s2 < 2; ++s2) {
              bf16x8 pf = pack_frag(Sx, s2);
#pragma unroll
              for (int pt = 0; pt < 2; ++pt) O[pt] = MFMA(ld_frag8x2(sX + (32 * pt + lr) * 136 + 32 * st + 16 * s2 + 4 * hh), pf, O[pt]);
            }
          }
        }
#pragma unroll
        for (int pt = 0; pt < 2; ++pt)
#pragma unroll
          for (int q4 = 0; q4 < 4; ++q4) {
            u16* zp = Z + (size_t)(tok0 + l) * 1024 + h * 64 + 32 * pt + 8 * q4 + 4 * hh;
            const uint2 zz = zv[pt][q4];
            float y0 = O[pt][4 * q4 + 0] * siluf_(blo(zz.x));
            float y1 = O[pt][4 * q4 + 1] * siluf_(bhi(zz.x));
            float y2 = O[pt][4 * q4 + 2] * siluf_(blo(zz.y));
            float y3 = O[pt][4 * q4 + 3] * siluf_(bhi(zz.y));
            uint2 o; o.x = pk2(y0, y1); o.y = pk2(y2, y3);
            *(uint2*)zp = o;
          }
      }
    }
  }
  grid.sync();

  {
    const float* w0 = p.in[10]; const float* a0 = p.in[12];
    auto epiw = [&](int mw, int nw, f32x16 (&acc)[2][2]) __attribute__((always_inline)) {
#pragma unroll
      for (int i = 0; i < 2; ++i)
#pragma unroll
        for (int j = 0; j < 2; ++j) {
          const int n = nw + 32 * j + lr; const float w0n = w0[n];
#pragma unroll
          for (int r = 0; r < 16; ++r) {
            float wr = -softplusf_(-(w0n + acc[i][j][r])) - 0.5f;
            WE[(size_t)(mw + 32 * i + crow(r, hh)) * 1024 + n] = f2bf(__expf(wr));
          }
        }
    };
    auto epia = [&](int mw, int nw, f32x16 (&acc)[2][2]) __attribute__((always_inline)) {
#pragma unroll
      for (int i = 0; i < 2; ++i)
#pragma unroll
        for (int j = 0; j < 2; ++j) {
          const int n = nw + 32 * j + lr; const float a0n = a0[n];
#pragma unroll
          for (int r = 0; r < 16; ++r) AA[(size_t)(mw + 32 * i + crow(r, hh)) * 1024 + n] = f2bf(sigmoidf_(a0n + acc[i][j][r]));
        }
    };
    gemm_phase22(LIN, 256, LIN, 256, 64, W2T, 64, 64, M_, 1024, smem, epiw, bid, nb);
    gemm_phase22(LIN + 64, 256, LIN + 64, 256, 64, A2T, 64, 64, M_, 1024, smem, epia, bid, nb);
    gemm_phase22(LIN + 128, 256, LIN + 128, 256, 128, G2T, 128, 128, M_, 1024, smem, EpiBf16{GG, 1024, smem}, bid, nb);
  }
  grid.sync();

  {
    float* sr = smf; float* sw = sr + 2048; float* sk = sw + 2048; float* sa = sk + 2048; float* sb = sa + 2048;
    float* sv = sb + 2048;
    float* sy = sv + 512;
    const float* mu = p.in[9]; const float* kkp = p.in[15]; const float* kap = p.in[16];
    for (int rpt = 0; rpt < RPT_SCAN; ++rpt)
    for (int task = bid; task < 256; task += nb) {
      const int bhh = task >> 2, rq = task & 3, b = bhh >> 4, h = bhh & 15;
      const int pt_ = tid >> 3, jg = tid & 7, ch = h * 64 + 8 * jg;
      float mur[8], muk[8], muv[8], kkw[8], kaw[8];
#pragma unroll
      for (int q = 0; q < 8; ++q) { mur[q] = mu[ch + q]; muk[q] = mu[1024 + ch + q]; muv[q] = mu[2048 + ch + q]; kkw[q] = kkp[ch + q]; kaw[q] = kap[ch + q]; }
      const int row = tid >> 4, jq = tid & 15;
      float S0 = 0.f, S1 = 0.f, S2 = 0.f, S3 = 0.f;
      u32x4 gr, gk, gv, gpr, gpk, gpv, gwe, gaa;
#define ISSUE(tc_) { \
        const int s = (tc_) * 32 + pt_; \
        const size_t gt = (size_t)b * 4096 + s; \
        const u16* cur = RW + gt * 3328 + ch; \
        gr = *(const u32x4*)cur; gk = *(const u32x4*)(cur + 1024); gv = *(const u32x4*)(cur + 2048); \
        if (s > 0) { gpr = *(const u32x4*)(cur - 3328); gpk = *(const u32x4*)(cur - 3328 + 1024); gpv = *(const u32x4*)(cur - 3328 + 2048); } \
        else { gpr = (u32x4){0u, 0u, 0u, 0u}; gpk = gpr; gpv = gpr; } \
        gwe = *(const u32x4*)(WE + gt * 1024 + ch); gaa = *(const u32x4*)(AA + gt * 1024 + ch); }
      ISSUE(0);
      for (int tc = 0; tc < 128; ++tc) {
        __syncthreads();
        {
          float r[8], k[8], v[8], pr[8], pk[8], pv[8], we[8], aa[8];
          unpack8(gr, r); unpack8(gk, k); unpack8(gv, v); unpack8(gpr, pr); unpack8(gpk, pk); unpack8(gpv, pv); unpack8(gwe, we); unpack8(gaa, aa);
          float kk[8], ss = 0.f;
#pragma unroll
          for (int q = 0; q < 8; ++q) {
            r[q] += (pr[q] - r[q]) * mur[q]; k[q] += (pk[q] - k[q]) * muk[q]; v[q] += (pv[q] - v[q]) * muv[q];
            kk[q] = k[q] * kkw[q]; ss += kk[q] * kk[q];
          }
          ss += __shfl_xor(ss, 1); ss += __shfl_xor(ss, 2); ss += __shfl_xor(ss, 4);
          const float inv = rsqrtf(fmaxf(ss, 1e-24f));
          float o_w[8], o_k[8], o_a[8], o_b[8];
#pragma unroll
          for (int q = 0; q < 8; ++q) {
            kk[q] *= inv;
            o_w[q] = __expf(-we[q]);
            o_k[q] = k[q] * (1.f + (aa[q] - 1.f) * kaw[q]);
            o_a[q] = -kk[q]; o_b[q] = kk[q] * aa[q];
          }
          const int o = pt_ * 64 + 8 * jg;
          *(float4*)(sr + o) = make_float4(r[0], r[1], r[2], r[3]); *(float4*)(sr + o + 4) = make_float4(r[4], r[5], r[6], r[7]);
          *(float4*)(sw + o) = make_float4(o_w[0], o_w[1], o_w[2], o_w[3]); *(float4*)(sw + o + 4) = make_float4(o_w[4], o_w[5], o_w[6], o_w[7]);
          *(float4*)(sk + o) = make_float4(o_k[0], o_k[1], o_k[2], o_k[3]); *(float4*)(sk + o + 4) = make_float4(o_k[4], o_k[5], o_k[6], o_k[7]);
          *(float4*)(sa + o) = make_float4(o_a[0], o_a[1], o_a[2], o_a[3]); *(float4*)(sa + o + 4) = make_float4(o_a[4], o_a[5], o_a[6], o_a[7]);
          *(float4*)(sb + o) = make_float4(o_b[0], o_b[1], o_b[2], o_b[3]); *(float4*)(sb + o + 4) = make_float4(o_b[4], o_b[5], o_b[6], o_b[7]);
          if ((jg >> 1) == rq) {
            const int ov = pt_ * 16 + 8 * (jg & 1);
            *(float4*)(sv + ov) = make_float4(v[0], v[1], v[2], v[3]); *(float4*)(sv + ov + 4) = make_float4(v[4], v[5], v[6], v[7]);
          }
        }
        if (tc + 1 < 128) ISSUE(tc + 1);
        __syncthreads();
        {
          const int bit0 = jq & 1, bit1 = (jq >> 1) & 1;
#pragma unroll 2
          for (int t0 = 0; t0 < 32; t0 += 4) {
            float4 w4[4], k4[4], a4[4], b4[4], r4[4]; float vv[4];
#pragma unroll
            for (int u = 0; u < 4; ++u) {
              const int t = t0 + u;
              w4[u] = *(const float4*)(sw + t * 64 + 4 * jq);
              k4[u] = *(const float4*)(sk + t * 64 + 4 * jq);
              a4[u] = *(const float4*)(sa + t * 64 + 4 * jq);
              b4[u] = *(const float4*)(sb + t * 64 + 4 * jq);
              r4[u] = *(const float4*)(sr + t * 64 + 4 * jq);
              vv[u] = sv[t * 16 + row];
            }
            float yq[4];
#pragma unroll
            for (int u = 0; u < 4; ++u) {
              const float part = S0 * a4[u].x + S1 * a4[u].y + S2 * a4[u].z + S3 * a4[u].w;
              const float sa_ = row16_sum(part);
              S0 = S0 * w4[u].x + vv[u] * k4[u].x + sa_ * b4[u].x;
              S1 = S1 * w4[u].y + vv[u] * k4[u].y + sa_ * b4[u].y;
              S2 = S2 * w4[u].z + vv[u] * k4[u].z + sa_ * b4[u].z;
              S3 = S3 * w4[u].w + vv[u] * k4[u].w + sa_ * b4[u].w;
              yq[u] = S0 * r4[u].x + S1 * r4[u].y + S2 * r4[u].z + S3 * r4[u].w;
            }
            float u0 = bit0 ? yq[2] : yq[0], u1 = bit0 ? yq[3] : yq[1];
            const float s0 = bit0 ? yq[0] : yq[2], s1 = bit0 ? yq[1] : yq[3];
            u0 += dppf<0xB1>(s0); u1 += dppf<0xB1>(s1);
            float kq = bit1 ? u1 : u0; const float sq2 = bit1 ? u0 : u1;
            kq += dppf<0x4E>(sq2);
            kq += dppf<0x124>(kq);
            kq += dppf<0x128>(kq);
            if (jq < 4) sy[(t0 + 2 * bit0 + bit1) * 16 + row] = kq;
          }
        }
        __syncthreads();
        {
          const int t = tid >> 3, pr2 = tid & 7;
          const size_t gt = (size_t)b * 4096 + tc * 32 + t;
          *(unsigned*)(YR + gt * 1024 + h * 64 + 16 * rq + 2 * pr2) = pk2(sy[t * 16 + 2 * pr2], sy[t * 16 + 2 * pr2 + 1]);
        }
      }
    }
  }
  grid.sync();

  {
    const float* ng = p.in[8]; const float* mu = p.in[9]; const float* kap = p.in[16]; const float* rkp = p.in[17];
    const float* lg = p.in[18]; const float* lb = p.in[19];
    for (int tok = bid * 4 + wave; tok < M_; tok += nb * 4) {
      const int c0 = 16 * lane, s = tok & 4095;
      u16* zp = Z + (size_t)tok * 1024 + c0;
      u16* yp = YR + (size_t)tok * 1024 + c0;
      const u16* cur = RW + (size_t)tok * 3328 + c0;
      const u16* prv = (s > 0) ? cur - 3328 : cur;
      const u16* ap = AA + (size_t)tok * 1024 + c0;
      const u16* gp = GG + (size_t)tok * 1024 + c0;
      u32x4 lz[2], ly[2], lc[6], lp[6], la[2], lgq[2];
      lz[0] = *(const u32x4*)zp; lz[1] = *(const u32x4*)(zp + 8);
      ly[0] = *(const u32x4*)yp; ly[1] = *(const u32x4*)(yp + 8);
#pragma unroll
      for (int i = 0; i < 3; ++i) {
        lc[2 * i] = *(const u32x4*)(cur + 1024 * i); lc[2 * i + 1] = *(const u32x4*)(cur + 1024 * i + 8);
        lp[2 * i] = *(const u32x4*)(prv + 1024 * i); lp[2 * i + 1] = *(const u32x4*)(prv + 1024 * i + 8);
      }
      la[0] = *(const u32x4*)ap; la[1] = *(const u32x4*)(ap + 8);
      lgq[0] = *(const u32x4*)gp; lgq[1] = *(const u32x4*)(gp + 8);
      const float pm = (s > 0) ? 1.f : 0.f;
      float zo[16];
      {
        unpack8(lz[0], zo); unpack8(lz[1], zo + 8);
        float ss = 0.f;
#pragma unroll
        for (int q = 0; q < 16; ++q) ss += zo[q] * zo[q];
#pragma unroll
        for (int o = 16; o > 0; o >>= 1) ss += __shfl_xor(ss, o);
        const float rs = rsqrtf(ss * (1.f / 512.f) + 1e-5f);
#pragma unroll
        for (int q = 0; q < 16; ++q) zo[q] = zo[q] * rs * ng[c0 + q];
      }
      float y[16];
      {
        float r[16], k[16], v[16], a[16], gg[16], tmp[16];
        unpack8(ly[0], y); unpack8(ly[1], y + 8);
        unpack8(lc[0], r); unpack8(lc[1], r + 8);
        unpack8(lc[2], k); unpack8(lc[3], k + 8);
        unpack8(lc[4], v); unpack8(lc[5], v + 8);
        unpack8(lp[0], tmp); unpack8(lp[1], tmp + 8);
#pragma unroll
        for (int q = 0; q < 16; ++q) r[q] += (tmp[q] * pm - r[q]) * mu[c0 + q];
        unpack8(lp[2], tmp); unpack8(lp[3], tmp + 8);
#pragma unroll
        for (int q = 0; q < 16; ++q) k[q] += (tmp[q] * pm - k[q]) * mu[1024 + c0 + q];
        unpack8(lp[4], tmp); unpack8(lp[5], tmp + 8);
#pragma unroll
        for (int q = 0; q < 16; ++q) v[q] += (tmp[q] * pm - v[q]) * mu[2048 + c0 + q];
        unpack8(la[0], a); unpack8(la[1], a + 8);
        unpack8(lgq[0], gg); unpack8(lgq[1], gg + 8);
        float sm = 0.f, dot = 0.f;
#pragma unroll
        for (int q = 0; q < 16; ++q) {
          sm += y[q];
          const float k2 = k[q] * (1.f + (a[q] - 1.f) * kap[c0 + q]);
          dot += r[q] * k2 * rkp[c0 + q];
        }
        sm += __shfl_xor(sm, 1); sm += __shfl_xor(sm, 2);
        dot += __shfl_xor(dot, 1); dot += __shfl_xor(dot, 2);
        const float mean = sm * (1.f / 64.f);
        float vs = 0.f;
#pragma unroll
        for (int q = 0; q < 16; ++q) { const float d = y[q] - mean; vs += d * d; }
        vs += __shfl_xor(vs, 1); vs += __shfl_xor(vs, 2);
        const float rs = rsqrtf(vs * (1.f / 64.f) + 64e-5f);
#pragma unroll
        for (int q = 0; q < 16; ++q) y[q] = ((y[q] - mean) * rs * lg[c0 + q] + lb[c0 + q] + dot * v[q]) * gg[q];
      }
      *(uint4*)zp = pack8(zo); *(uint4*)(zp + 8) = pack8(zo + 8);
      *(uint4*)yp = pack8(y); *(uint4*)(yp + 8) = pack8(y + 8);
    }
  }
  grid.sync();

  gemm_phase22(Z, 1024, YR, 1024, 1024, WOUT, 2048, 2048, M_, 1024, smem, EpiResid{p.in[0], p.out}, bid, nb);
  grid.sync();

  ln_phase(p.out, p.in[23], p.in[24], XB, bid, nb);
  conv_weight(p.in[21], 1024, 3072, 3072, (u16*)(ws + OFF_QKV1), 0, smf, bid, nb);
  conv_weight(p.in[22], 1024, 1024, 1024, (u16*)(ws + OFF_OUT1), 0, smf, bid, nb);
  for (int l = 0; l < 2; ++l) {
    char* lw = ws + OFF_LW + LW_STRIDE * l;
    conv_weight(p.in[25] + (size_t)l * 1024 * 1024, 1024, 1024, 1024, (u16*)(lw + LW_WQ), 0, smf, bid, nb);
    conv_weight(p.in[26] + (size_t)l * 1024 * 2048, 1024, 2048, 2048, (u16*)(lw + LW_WKV), 0, smf, bid, nb);
    conv_weight(p.in[27] + (size_t)l * 1024 * 1024, 1024, 1024, 1024, (u16*)(lw + LW_WO), 0, smf, bid, nb);
    conv_weight(p.in[30] + (size_t)l * 1024 * 2 * FFN_H, 1024, 2 * FFN_H, 2 * FFN_H, (u16*)(lw + LW_W13), 1, smf, bid, nb);
    conv_weight(p.in[31] + (size_t)l * FFN_H * 1024, FFN_H, 1024, 1024, (u16*)(lw + LW_W2F), 0, smf, bid, nb);
  }
  grid.sync();

  xattn_ffn(p, 0, grid, smem, bid, nb, true);

  {
    u16* Q1 = (u16*)(ws + OFF_S0); u16* K1 = (u16*)(ws + OFF_S1); u16* V1T = (u16*)(ws + OFF_S2); u16* O1 = (u16*)(ws + OFF_S3);
    {
      auto epi = [&](int mw, int nw, f32x16 (&acc)[2][2]) __attribute__((always_inline)) {
        const int wv = tid >> 6;
        const int m0 = mw - (wv >> 1) * 64, n0 = nw - (wv & 1) * 64;
        if (n0 < 2048) {
          u16* dst = (n0 < 1024) ? Q1 : K1;
          const int nn = n0 & 1023;
          stage_tile<0>(acc, smem, [&](int rr, int cc, const u32x4& v) __attribute__((always_inline)) { *(u32x4*)(dst + (size_t)(m0 + rr) * 1024 + nn + cc) = v; });
        } else {
          stage_tile<1>(acc, smem, [&](int rr, int cc, const u32x4& v) __attribute__((always_inline)) {
            const int c = n0 - 2048 + rr, m = m0 + cc;
            *(u32x4*)(V1T + ((size_t)((m >> 12) * 1024 + c)) * 4096 + (m & 4095)) = v;
          });
        }
      };
      gemm_phase22(XB, 1024, XB, 1024, 1024, (const u16*)(ws + OFF_QKV1), 1024, 1024, M_, 3072, smem, epi, bid, nb);
    }
    grid.sync();
    for (int t = bid; t < 1024; t += nb) {
      const int bhh = t >> 4, blk = t & 15, b = bhh >> 4, h = bhh & 15;
      const int d = tid & 63, part = tid >> 6;
      float s = 0.f;
      const u16* src = K1 + ((size_t)b * 4096 + blk * 256 + part * 64) * 1024 + h * 64 + d;
      for (int i = 0; i < 64; ++i) s += bf2f(src[(size_t)i * 1024]);
      __syncthreads();
      smf[part * 64 + d] = s;
      __syncthreads();
      if (tid < 64) KMEAN[(size_t)t * 64 + tid] = (smf[tid] + smf[64 + tid] + smf[128 + tid] + smf[192 + tid]) * (1.f / 256.f);
    }
    grid.sync();
    {
      float* skm = smf;
      int* slist = (int*)(smf + 1024);
      u16* sKV = smem + 4096;
      for (int rpt = 0; rpt < RPT_MOBA; ++rpt)
      for (int t = bid; t < 2048; t += nb) {
        const int rnd = t >> 9, g8 = (t >> 6) & 7;
        const int qt = (rnd == 0) ? 31 - g8 : (rnd == 1) ? g8 : (rnd == 2) ? 23 - g8 : 8 + g8;
        const int bhh = t & 63, b = bhh >> 4, h = bhh & 15, own = qt >> 1;
        __syncthreads();
        for (int i = tid; i < 1024; i += 256) skm[i] = KMEAN[(size_t)bhh * 1024 + i];
        if (tid == 0) slist[65] = 0;
        __syncthreads();
        const int sq = qt * 128 + 32 * wave + lr;
        const size_t tokq = (size_t)b * 4096 + sq;
        bf16x8 qf[4];
#pragma unroll
        for (int ks = 0; ks < 4; ++ks) qf[ks] = ld_frag16(Q1 + tokq * 1024 + h * 64 + 16 * ks + 8 * hh);
        unsigned sel = 0;
        {
          float qv[32];
#pragma unroll
          for (int i = 0; i < 4; ++i) unpack8(*(const u32x4*)(Q1 + tokq * 1024 + h * 64 + 32 * hh + 8 * i), qv + 8 * i);
          float v0 = -INFINITY, v1 = -INFINITY, v2 = -INFINITY; int i0 = -1, i1 = -1, i2 = -1;
          for (int n = 0; n < own; ++n) {
            float part = 0.f;
#pragma unroll
            for (int d = 0; d < 32; ++d) part += qv[d] * skm[n * 64 + 32 * hh + d];
            const float gsc = part + __shfl_xor(part, 32);
            if (gsc > v0) { v2 = v1; i2 = i1; v1 = v0; i1 = i0; v0 = gsc; i0 = n; }
            else if (gsc > v1) { v2 = v1; i2 = i1; v1 = gsc; i1 = n; }
            else if (gsc > v2) { v2 = gsc; i2 = n; }
          }
          if (i0 >= 0) sel |= 1u << i0;
          if (i1 >= 0) sel |= 1u << i1;
          if (i2 >= 0) sel |= 1u << i2;
        }
        unsigned wsel = sel;
#pragma unroll
        for (int o = 1; o < 64; o <<= 1) wsel |= (unsigned)__shfl_xor((int)wsel, o);
        if (lane == 0) atomicOr((unsigned*)&slist[65], wsel);
        __syncthreads();
        if (tid == 0) {
          const unsigned bm = (unsigned)slist[65];
          int n = 0;
          for (int j = 0; j < own; ++j)
            if ((bm >> j) & 1u) for (int kt = 0; kt < 4; ++kt) slist[n++] = (j << 8) | kt;
          const int nown = (qt & 1) * 2 + 2;
          for (int kt = 0; kt < nown; ++kt) slist[n++] = (own << 8) | kt;
          slist[64] = n;
        }
        __syncthreads();
        const int ntile = slist[64];
        f32x16 O[2];
#pragma unroll
        for (int r = 0; r < 16; ++r) { O[0][r] = 0.f; O[1][r] = 0.f; }
        float mrun = -1e30f, lrun = 0.f;
        u32x4 gk0, gk1, gv0, gv1;
        const int lrow = tid >> 2, lcol = (tid & 3) * 16;
#define KV_LOAD(e_) { const int j_ = (e_) >> 8, kt_ = (e_) & 255; const int key0_ = j_ * 256 + kt_ * 64; \
          const u16* kp_ = K1 + ((size_t)b * 4096 + key0_ + lrow) * 1024 + h * 64 + lcol; gk0 = *(const u32x4*)kp_; gk1 = *(const u32x4*)(kp_ + 8); \
          const u16* vp_ = V1T + ((size_t)(bhh * 64 + lrow)) * 4096 + key0_ + lcol; gv0 = *(const u32x4*)vp_; gv1 = *(const u32x4*)(vp_ + 8); }
#define KV_STORE(buf_) { u16* kb_ = sKV + (buf_) * 9216; *(u32x4*)(kb_ + lrow * 72 + lcol) = gk0; *(u32x4*)(kb_ + lrow * 72 + lcol + 8) = gk1; \
          u16* vb_ = kb_ + 4608; *(u32x4*)(vb_ + lrow * 72 + lcol) = gv0; *(u32x4*)(vb_ + lrow * 72 + lcol + 8) = gv1; }
        KV_LOAD(slist[0]);
        KV_STORE(0);
        __syncthreads();
        const float SC = 0.125f * 1.44269504088896f;
        for (int i = 0; i < ntile; ++i) {
          const int e = slist[i]; const int j = e >> 8, kt = e & 255;
          const bool more = (i + 1 < ntile);
          if (more) KV_LOAD(slist[i + 1]);
          const bool isown = (j == own);
          const bool lsel = isown || ((sel >> j) & 1u);
          const bool wact = isown || ((wsel >> j) & 1u);
          if (wact) {
            const u16* kb = sKV + (i & 1) * 9216; const u16* vb = kb + 4608;
#pragma unroll
            for (int sub = 0; sub < 2; ++sub) {
              const int key0 = j * 256 + kt * 64 + 32 * sub;
              if (isown && key0 > qt * 128 + 32 * wave + 31) continue;
              f32x16 Sx;
#pragma unroll
              for (int r = 0; r < 16; ++r) Sx[r] = 0.f;
              __builtin_amdgcn_s_setprio(1);
#pragma unroll
              for (int ks = 0; ks < 4; ++ks) {
                bf16x8 kf = *(const bf16x8*)(kb + (32 * sub + lr) * 72 + 16 * ks + 8 * hh);
                Sx = MFMA(kf, qf[ks], Sx);
              }
              __builtin_amdgcn_s_setprio(0);
              float tmx = -1e30f, ls = 0.f, mnew, alpha;
              if (isown) {
#pragma unroll
                for (int r = 0; r < 16; ++r) {
                  Sx[r] *= SC;
                  if (key0 + crow(r, hh) <= sq) tmx = fmaxf(tmx, Sx[r]);
                }
                tmx = fmaxf(tmx, __shfl_xor(tmx, 32));
                mnew = fmaxf(mrun, tmx);
                alpha = __builtin_amdgcn_exp2f(mrun - mnew);
#pragma unroll
                for (int r = 0; r < 16; ++r) {
                  const float pe = (key0 + crow(r, hh) <= sq) ? __builtin_amdgcn_exp2f(Sx[r] - mnew) : 0.f;
                  Sx[r] = pe; ls += pe;
                }
              } else {
#pragma unroll
                for (int r = 0; r < 16; ++r) tmx = fmaxf(tmx, Sx[r]);
                tmx = lsel ? tmx * SC : -1e30f;
                tmx = fmaxf(tmx, __shfl_xor(tmx, 32));
                mnew = fmaxf(mrun, tmx);
                alpha = __builtin_amdgcn_exp2f(mrun - mnew);
                const float lm = lsel ? 1.f : 0.f;
#pragma unroll
                for (int r = 0; r < 16; ++r) {
                  const float pe = __builtin_amdgcn_exp2f(fminf(__builtin_fmaf(Sx[r], SC, -mnew), 0.f)) * lm;
                  Sx[r] = pe; ls += pe;
                }
              }
              ls += __shfl_xor(ls, 32);
              lrun = lrun * alpha + ls; mrun = mnew;
#pragma unroll
              for (int r = 0; r < 16; ++r) { O[0][r] *= alpha; O[1][r] *= alpha; }
#pragma unroll
              for (int s2 = 0; s2 < 2; ++s2) {
                bf16x8 pf = pack_frag(Sx, s2);
#pragma unroll
                for (int dt = 0; dt < 2; ++dt) {
                  bf16x8 af = ld_frag8x2(vb + (32 * dt + lr) * 72 + 32 * sub + 16 * s2 + 4 * hh);
                  O[dt] = MFMA(af, pf, O[dt]);
                }
              }
            }
          }
          if (more) KV_STORE((i + 1) & 1);
          __syncthreads();
        }
        const float inv = 1.f / lrun;
#pragma unroll
        for (int dt = 0; dt < 2; ++dt)
#pragma unroll
          for (int q4 = 0; q4 < 4; ++q4) {
            uint2 o; o.x = pk2(O[dt][4 * q4] * inv, O[dt][4 * q4 + 1] * inv); o.y = pk2(O[dt][4 * q4 + 2] * inv, O[dt][4 * q4 + 3] * inv);
            *(uint2*)(O1 + tokq * 1024 + h * 64 + 32 * dt + 8 * q4 + 4 * hh) = o;
          }
      }
    }
    grid.sync();
    gemm_phase22(O1, 1024, O1, 1024, 1024, (const u16*)(ws + OFF_OUT1), 1024, 1024, M_, 1024, smem, EpiResid{p.out, p.out}, bid, nb);
    grid.sync();
    ln_phase(p.out, p.in[23] + 1024, p.in[24] + 1024, XB, bid, nb);
    grid.sync();
  }
  xattn_ffn(p, 1, grid, smem, bid, nb, true);
}

extern "C" void kernel_launch(void* const* d_in, const int* in_sizes, int n_in, void* d_out, int out_size, void* d_ws, size_t ws_size,
                              hipStream_t stream) {
  static int grid_blocks = 0;
  if (!grid_blocks) {
    int dev = 0, cus = 0, per_cu = 0;
    hipGetDevice(&dev);
    hipDeviceGetAttribute(&cus, hipDeviceAttributeMultiprocessorCount, dev);
    hipOccupancyMaxActiveBlocksPerMultiprocessor(&per_cu, fwd_megakernel, 256, 0);
    if (per_cu > 2) per_cu = 2;
    if (per_cu < 1) per_cu = 1;
    grid_blocks = cus * per_cu;
  }
  Params p{};
  for (int i = 0; i < 34; ++i) p.in[i] = (const float*)d_in[i];
  p.out = (float*)d_out;
  p.ws = (char*)d_ws;
  hipMemsetAsync((char*)d_ws + OFF_BAR, 0, XCD_BAR_WORDS * sizeof(unsigned), stream);
  void* args[] = {&p};
  hipError_t e = hipLaunchCooperativeKernel((void*)fwd_megakernel, dim3(grid_blocks), dim3(256), args, 0, stream);
  if (e != hipSuccess) fprintf(stderr, "cooperative launch failed: %s (grid %d)\n", hipGetErrorString(e), grid_blocks);
}
```

```cpp
#include <hip/hip_runtime.h>
#include <hip/hip_cooperative_groups.h>
#include <stdint.h>
#include <cstdio>
namespace cg = cooperative_groups;
#define DI __device__ __forceinline__
typedef unsigned short u16;
using bf16x8 = __attribute__((ext_vector_type(8))) short;
using f32x16 = __attribute__((ext_vector_type(16))) float;
using u32x4 = __attribute__((ext_vector_type(4))) unsigned;
#define FRESH_TID() ({ int t_ = (int)threadIdx.x; asm volatile("" : "+v"(t_)); t_; })
#define MFMA(a, b, c) __builtin_amdgcn_mfma_f32_32x32x16_bf16((a), (b), (c), 0, 0, 0)

constexpr int NB_ = 4, S_ = 4096, D_ = 1024, M_ = NB_ * S_;
constexpr int EVEN_IN = 5904, EVEN_IN_PAD = 6016, FFN_H = 2816;
constexpr float ALPHA = 1.41421356237309515f;
constexpr size_t MiB = 1ull << 20;
constexpr size_t OFF_RW = 0, OFF_XBC = 104 * MiB, OFF_Z = 152 * MiB, OFF_WIN = 184 * MiB;
constexpr size_t OFF_WOUT = OFF_WIN + (size_t)EVEN_IN_PAD * 1024 * 2;
constexpr size_t OFF_XB = OFF_WOUT + 4 * MiB;
constexpr size_t OFF_DT = OFF_XB + 32 * MiB;
constexpr size_t OFF_LIN = OFF_DT + 1 * MiB;
constexpr size_t OFF_MEMB = OFF_LIN + 8 * MiB;
constexpr size_t OFF_XAK = OFF_MEMB + 2 * MiB;
constexpr size_t OFF_XAVT = OFF_XAK + 4 * MiB;
constexpr size_t OFF_KMEAN = OFF_XAVT + 4 * MiB;
constexpr size_t OFF_CDEC = OFF_KMEAN + MiB / 4;
constexpr size_t OFF_LORAW = OFF_CDEC + MiB / 4;
constexpr size_t OFF_STATES = OFF_XB, OFF_GG = OFF_XB, OFF_YR = OFF_XBC;
constexpr size_t DO_XT = 0, DO_BM = 32 * MiB, DO_BMT = 40 * MiB, DO_CM = 48 * MiB, DO_WE = 0, DO_AA = 32 * MiB;
constexpr size_t OFF_QKV1 = 0, OFF_OUT1 = 6 * MiB, OFF_LW = 8 * MiB, LW_STRIDE = 49 * MiB / 2;
constexpr size_t LW_WQ = 0, LW_WKV = 2 * MiB, LW_WO = 6 * MiB, LW_W13 = 8 * MiB, LW_W2F = 19 * MiB;
constexpr size_t OFF_S0 = 57 * MiB, OFF_S1 = 89 * MiB, OFF_S2 = 121 * MiB, OFF_S3 = 153 * MiB;

#ifndef RPT_SCAN
#define RPT_SCAN 1
#endif
#ifndef RPT_MOBA
#define RPT_MOBA 1
#endif
#ifndef RPT_FFN
#define RPT_FFN 1
#endif

#define XB_TMO      128
#define XB_XCNT(j)  (256  + 64 * (j))
#define XB_XSUB(j)  (1280 + 64 * (j))
#define XB_XGEN(j)  (2304 + 64 * (j))
#define XB_TOP      3328
#define XB_TOPGEN   3392
#define XCD_BAR_WORDS 3456
#define XB_SPIN_CAP (1u << 18)
#define LAS __attribute__((address_space(3)))
DI unsigned xb_ld(unsigned* p)              { return __hip_atomic_load(p, __ATOMIC_RELAXED, __HIP_MEMORY_SCOPE_AGENT); }
DI unsigned xb_add(unsigned* p, unsigned v) { return __hip_atomic_fetch_add(p, v, __ATOMIC_RELAXED, __HIP_MEMORY_SCOPE_AGENT); }
DI unsigned xb_xcc_id() { return (unsigned)__builtin_amdgcn_s_getreg((3 << 11) | 20) & 0xFu; }
#define XB_SPIN(cond, bar) do { unsigned _sp = 0; while (cond) { __builtin_amdgcn_s_sleep(1); \
    if ((++_sp & 255u) == 0u) { if (xb_ld(&(bar)[XB_TMO])) break; if (_sp > XB_SPIN_CAP) { atomicAdd(&(bar)[XB_TMO], 1u); break; } } } } while (0)
struct XcdBarrier { unsigned* bar; unsigned x; volatile LAS unsigned* st; };
DI XcdBarrier xcd_barrier_post(unsigned* bar, volatile LAS unsigned* st) {
    XcdBarrier b; b.bar = bar; b.x = xb_xcc_id(); b.st = st;
    if (threadIdx.x == 0) (void)xb_add(&bar[XB_XCNT(b.x)], 1u);
    return b;
}
DI void xcd_barrier_complete(unsigned* bar, unsigned x, unsigned& nloc, unsigned& nx) {
    const unsigned G = gridDim.x * gridDim.y * gridDim.z;
    unsigned sum, cnt, mine, sp = 0u;
    for (;;) {
        sum = 0u; cnt = 0u; mine = 0u;
#pragma unroll
        for (unsigned j = 0; j < 16; ++j) { const unsigned c = xb_ld(&bar[XB_XCNT(j)]); sum += c; cnt += (c > 0u) ? 1u : 0u; mine = (j == x) ? c : mine; }
        if (sum == G) break;
        __builtin_amdgcn_s_sleep(1);
        if ((++sp & 255u) == 0u) { if (xb_ld(&bar[XB_TMO])) break; if (sp > XB_SPIN_CAP) { atomicAdd(&bar[XB_TMO], 1u); break; } }
    }
    nloc = mine > 0u ? mine : 1u; nx = cnt > 0u ? cnt : 1u;
}
DI void xcd_barrier(const XcdBarrier& b) {
    asm volatile("s_waitcnt vmcnt(0)" ::: "memory");
    __syncthreads();
    if (threadIdx.x == 0) {
        unsigned* bar = b.bar;
        __builtin_amdgcn_s_waitcnt(0);
        unsigned nloc = b.st[0], nx = b.st[1];
        if (nloc == 0u) { xcd_barrier_complete(bar, b.x, nloc, nx); b.st[0] = nloc; b.st[1] = nx; }
        const unsigned old = xb_add(&bar[XB_XSUB(b.x)], 1u);
        const unsigned gen = old / nloc;
        if (old + 1u == (gen + 1u) * nloc) {
            __builtin_amdgcn_fence(__ATOMIC_RELEASE, "agent");
            asm volatile("s_waitcnt vmcnt(0)" ::: "memory");
            const unsigned og = xb_add(&bar[XB_TOP], 1u);
            const unsigned tg = og / nx;
            if (og + 1u == (tg + 1u) * nx) xb_add(&bar[XB_TOPGEN], 1u);
            else XB_SPIN(xb_ld(&bar[XB_TOPGEN]) == tg, bar);
            __builtin_amdgcn_fence(__ATOMIC_ACQUIRE, "agent");
            xb_add(&bar[XB_XGEN(b.x)], 1u);
            asm volatile("s_waitcnt vmcnt(0)" ::: "memory");
        } else {
            XB_SPIN(xb_ld(&bar[XB_XGEN(b.x)]) == gen, bar);
            __builtin_amdgcn_fence(__ATOMIC_ACQUIRE, "agent");
            asm volatile("s_waitcnt vmcnt(0)" ::: "memory");
        }
    }
    __syncthreads();
}
struct GridBar { XcdBarrier b; DI void sync() const { xcd_barrier(b); } };
constexpr size_t OFF_BAR = 254 * MiB;
struct Params { const float* in[34]; float* out; char* ws; };

typedef __bf16 bf16x2_t __attribute__((ext_vector_type(2)));
typedef float f32x2_t __attribute__((ext_vector_type(2)));
DI u16 f2bf(float x) { return __builtin_bit_cast(u16, (__bf16)x); }
DI float bf2f(u16 b) { return __uint_as_float(((unsigned)b) << 16); }
DI unsigned pk2(float a, float b) { f32x2_t v = {a, b}; return __builtin_bit_cast(unsigned, __builtin_convertvector(v, bf16x2_t)); }
DI float blo(unsigned u) { return __uint_as_float(u << 16); }
DI float bhi(unsigned u) { return __uint_as_float(u & 0xffff0000u); }
template <class V4> DI void unpack8(const V4& v, float* f) {
  f[0] = blo(v.x); f[1] = bhi(v.x); f[2] = blo(v.y); f[3] = bhi(v.y); f[4] = blo(v.z); f[5] = bhi(v.z); f[6] = blo(v.w); f[7] = bhi(v.w);
}
DI uint4 pack8(const float* f) { uint4 v; v.x = pk2(f[0], f[1]); v.y = pk2(f[2], f[3]); v.z = pk2(f[4], f[5]); v.w = pk2(f[6], f[7]); return v; }
DI int crow(int r, int hh) { return (r & 3) + 8 * (r >> 2) + 4 * hh; }
DI float sigmoidf_(float x) { return __builtin_amdgcn_rcpf(1.f + __expf(-x)); }
DI float siluf_(float x) { return x * __builtin_amdgcn_rcpf(1.f + __expf(-x)); }
DI float softplusf_(float x) { return x > 20.f ? x : __logf(1.f + __expf(x)); }
template <int CTRL> DI float dppf(float v) { return __builtin_bit_cast(float, __builtin_amdgcn_update_dpp(0, __builtin_bit_cast(int, v), CTRL, 0xf, 0xf, true)); }
DI float row16_sum(float v) { v += dppf<0xB1>(v); v += dppf<0x4E>(v); v += dppf<0x141>(v); v += dppf<0x140>(v); return v; }
DI bf16x8 pack_frag(const f32x16& x, int s) {
  uint4 p;
  p.x = pk2(x[8 * s + 0], x[8 * s + 1]); p.y = pk2(x[8 * s + 2], x[8 * s + 3]);
  p.z = pk2(x[8 * s + 4], x[8 * s + 5]); p.w = pk2(x[8 * s + 6], x[8 * s + 7]);
  return __builtin_bit_cast(bf16x8, p);
}
DI bf16x8 ld_frag16(const u16* p) { return __builtin_bit_cast(bf16x8, *(const uint4*)p); }
DI bf16x8 ld_frag8x2(const u16* p) { uint2 a = *(const uint2*)p; uint2 b = *(const uint2*)(p + 8); uint4 v; v.x = a.x; v.y = a.y; v.z = b.x; v.w = b.y; return __builtin_bit_cast(bf16x8, v); }

template <int WM, int WN, class Epi>
DI void gemm_tile(const u16* __restrict__ A, int lda, const u16* __restrict__ A2, int lda2, int ksplit,
                  const u16* __restrict__ Bt, int ldb, int K, int m0, int n0, u16* smem, Epi&& epi) {
  constexpr int BM = 64 * WM, BN = 64 * WN, LD = 72;
  constexpr int NA = BM * 8 / 256, NBL = BN * 8 / 256;
  u16* sA = smem; u16* sB = smem + BM * LD;
  const int tid = threadIdx.x, lane = tid & 63, wave = tid >> 6, wm = wave >> 1, wn = wave & 1;
  u32x4 ra[NA], rb[NBL];
  f32x16 acc[WM][WN];
#pragma unroll
  for (int i = 0; i < WM; ++i)
#pragma unroll
    for (int j = 0; j < WN; ++j)
#pragma unroll
      for (int r = 0; r < 16; ++r) acc[i][j][r] = 0.f;
#define GLOAD(k0_) { const u16* Ap; int ld, kk; \
    if ((k0_) < ksplit) { Ap = A; ld = lda; kk = (k0_); } else { Ap = A2; ld = lda2; kk = (k0_) - ksplit; } \
    _Pragma("unroll") for (int i = 0; i < NA; ++i) { int c = tid + 256 * i; int row = c >> 3, col = (c & 7) * 8; ra[i] = *(const u32x4*)(Ap + (size_t)(m0 + row) * ld + kk + col); } \
    _Pragma("unroll") for (int i = 0; i < NBL; ++i) { int c = tid + 256 * i; int row = c >> 3, col = (c & 7) * 8; rb[i] = *(const u32x4*)(Bt + (size_t)(n0 + row) * ldb + (k0_) + col); } }
#define SSTORE() { \
    _Pragma("unroll") for (int i = 0; i < NA; ++i) { int c = tid + 256 * i; int row = c >> 3, col = (c & 7) * 8; *(u32x4*)(sA + row * LD + col) = ra[i]; } \
    _Pragma("unroll") for (int i = 0; i < NBL; ++i) { int c = tid + 256 * i; int row = c >> 3, col = (c & 7) * 8; *(u32x4*)(sB + row * LD + col) = rb[i]; } }
  constexpr bool DB = (2 * (BM + BN) * LD * 2 <= 72 * 1024);
  constexpr int STAGE = (BM + BN) * LD;
  const int lr = lane & 31, hh = lane >> 5;
  GLOAD(0);
  __syncthreads();
  SSTORE();
  __syncthreads();
  int buf = 0;
  for (int k0 = 0; k0 < K; k0 += 64) {
    const bool more = (k0 + 64 < K);
    if (more) GLOAD(k0 + 64);
    if constexpr (DB) __builtin_amdgcn_sched_barrier(0);
    __builtin_amdgcn_s_setprio(1);
    {
      const u16* cA = smem + (DB ? buf * STAGE : 0);
      const u16* cB = cA + BM * LD;
      if constexpr (DB) {
        bf16x8 af[2][WM], bfr[2][WN];
#pragma unroll
        for (int i = 0; i < WM; ++i) af[0][i] = *(const bf16x8*)(cA + (wm * 32 * WM + i * 32 + lr) * LD + hh * 8);
#pragma unroll
        for (int j = 0; j < WN; ++j) bfr[0][j] = *(const bf16x8*)(cB + (wn * 32 * WN + j * 32 + lr) * LD + hh * 8);
#pragma unroll
        for (int ks = 0; ks < 4; ++ks) {
          if (ks + 1 < 4) {
#pragma unroll
            for (int i = 0; i < WM; ++i) af[(ks + 1) & 1][i] = *(const bf16x8*)(cA + (wm * 32 * WM + i * 32 + lr) * LD + (ks + 1) * 16 + hh * 8);
#pragma unroll
            for (int j = 0; j < WN; ++j) bfr[(ks + 1) & 1][j] = *(const bf16x8*)(cB + (wn * 32 * WN + j * 32 + lr) * LD + (ks + 1) * 16 + hh * 8);
          }
#pragma unroll
          for (int i = 0; i < WM; ++i)
#pragma unroll
            for (int j = 0; j < WN; ++j) acc[i][j] = MFMA(af[ks & 1][i], bfr[ks & 1][j], acc[i][j]);
        }
      } else {
#pragma unroll
        for (int ks = 0; ks < 4; ++ks) {
          bf16x8 af[WM], bfr[WN];
#pragma unroll
          for (int i = 0; i < WM; ++i) af[i] = *(const bf16x8*)(cA + (wm * 32 * WM + i * 32 + lr) * LD + ks * 16 + hh * 8);
#pragma unroll
          for (int j = 0; j < WN; ++j) bfr[j] = *(const bf16x8*)(cB + (wn * 32 * WN + j * 32 + lr) * LD + ks * 16 + hh * 8);
#pragma unroll
          for (int i = 0; i < WM; ++i)
#pragma unroll
            for (int j = 0; j < WN; ++j) acc[i][j] = MFMA(af[i], bfr[j], acc[i][j]);
        }
      }
    }
    __builtin_amdgcn_s_setprio(0);
    if constexpr (DB) __builtin_amdgcn_sched_barrier(0);
    if (DB) {
      if (more) {
        u16* sA = smem + (buf ^ 1) * STAGE; u16* sB = sA + BM * LD;
        SSTORE();
      }
      __syncthreads();
      buf ^= 1;
    } else {
      __syncthreads();
      if (more) SSTORE();
      __syncthreads();
    }
  }
  epi(m0 + wm * 32 * WM, n0 + wn * 32 * WN, acc);
}

DI void conv_weight(const float* __restrict__ W, int K, int N, int Npad, u16* __restrict__ Wt, int mode, float* sT, int bid, int nb) {
  const int tid = threadIdx.x;
  const int ktn = K / 64, ntn = Npad / 128;
  for (int t = bid; t < ktn * ntn; t += nb) {
    const int kt = t / ntn, nt = t % ntn;
    float4 wv[8];
#pragma unroll
    for (int i = 0; i < 8; ++i) {
      int e = tid + 256 * i; int kk = e >> 5, nn = (e & 31) * 4; int n = nt * 128 + nn;
      wv[i] = (n < N) ? *(const float4*)(W + (size_t)(kt * 64 + kk) * N + n) : make_float4(0.f, 0.f, 0.f, 0.f);
    }
    __syncthreads();
#pragma unroll
    for (int i = 0; i < 8; ++i) {
      int e = tid + 256 * i; int kk = e >> 5, nn = (e & 31) * 4;
      sT[kk * 129 + nn] = wv[i].x; sT[kk * 129 + nn + 1] = wv[i].y; sT[kk * 129 + nn + 2] = wv[i].z; sT[kk * 129 + nn + 3] = wv[i].w;
    }
    __syncthreads();
#pragma unroll
    for (int i = 0; i < 4; ++i) {
      int c = tid + 256 * i; int nn = c >> 3, k8 = (c & 7) * 8;
      float f[8];
#pragma unroll
      for (int q = 0; q < 8; ++q) f[q] = sT[(k8 + q) * 129 + nn];
      int n = nt * 128 + nn, row = n;
      if (mode == 1) { int j = (n < FFN_H) ? n : n - FFN_H; row = (j >> 5) * 64 + (j & 31) + ((n < FFN_H) ? 0 : 32); }
      *(uint4*)(Wt + (size_t)row * K + kt * 64 + k8) = pack8(f);
    }
  }
}

DI void conv_act(const float* __restrict__ src, u16* __restrict__ dst, size_t n, int bid, int nb) {
  const size_t stride = (size_t)nb * 256 * 8;
  size_t i = ((size_t)bid * 256 + threadIdx.x) * 8;
  for (; i + 3 * stride < n; i += 4 * stride) {
    float4 a[4], b[4];
#pragma unroll
    for (int u = 0; u < 4; ++u) { a[u] = *(const float4*)(src + i + u * stride); b[u] = *(const float4*)(src + i + u * stride + 4); }
#pragma unroll
    for (int u = 0; u < 4; ++u) {
      float f[8] = {a[u].x, a[u].y, a[u].z, a[u].w, b[u].x, b[u].y, b[u].z, b[u].w};
      *(uint4*)(dst + i + u * stride) = pack8(f);
    }
  }
  for (; i < n; i += stride) {
    float4 a = *(const float4*)(src + i), b = *(const float4*)(src + i + 4);
    float f[8] = {a.x, a.y, a.z, a.w, b.x, b.y, b.z, b.w};
    *(uint4*)(dst + i) = pack8(f);
  }
}

DI void ln_phase(float* __restrict__ X, const float* __restrict__ g, const float* __restrict__ bta, u16* __restrict__ XB, int bid, int nb) {
  const int lane = threadIdx.x & 63, wave = threadIdx.x >> 6;
  for (int row = bid * 4 + wave; row < M_; row += nb * 4) {
    float* xr = X + (size_t)row * 1024;
    float4 v[4];
    float s = 0.f;
#pragma unroll
    for (int i = 0; i < 4; ++i) { v[i] = *(const float4*)(xr + 4 * lane + 256 * i); s += v[i].x + v[i].y + v[i].z + v[i].w; }
#pragma unroll
    for (int o = 32; o > 0; o >>= 1) s += __shfl_xor(s, o);
    const float mu = s * (1.f / 1024.f);
    float q = 0.f;
#pragma unroll
    for (int i = 0; i < 4; ++i) { float a = v[i].x - mu, b = v[i].y - mu, c = v[i].z - mu, d = v[i].w - mu; q += a * a + b * b + c * c + d * d; }
#pragma unroll
    for (int o = 32; o > 0; o >>= 1) q += __shfl_xor(q, o);
    const float rs = rsqrtf(q * (1.f / 1024.f) + 1e-5f);
#pragma unroll
    for (int i = 0; i < 4; ++i) {
      const int c = 4 * lane + 256 * i;
      float4 gg = *(const float4*)(g + c), bb = *(const float4*)(bta + c), o;
      o.x = (v[i].x - mu) * rs * gg.x + bb.x; o.y = (v[i].y - mu) * rs * gg.y + bb.y;
      o.z = (v[i].z - mu) * rs * gg.z + bb.z; o.w = (v[i].w - mu) * rs * gg.w + bb.w;
      *(float4*)(xr + c) = o;
      uint2 pb; pb.x = pk2(o.x, o.y); pb.y = pk2(o.z, o.w);
      *(uint2*)(XB + (size_t)row * 1024 + c) = pb;
    }
  }
}

DI void block_cumsum128(float* s) {
  const int tid = threadIdx.x, lane = tid & 63;
  __syncthreads();
  float v = (tid < 128) ? s[tid] : 0.f;
#pragma unroll
  for (int off = 1; off < 64; off <<= 1) { const float u = __shfl_up(v, off); if (lane >= off) v += u; }
  if (tid < 64) s[tid] = v;
  __syncthreads();
  if (tid >= 64 && tid < 128) s[tid] = v + s[63];
  __syncthreads();
}

struct EpiResid {
  const float* R; float* X;
  template <class ACC> DI void operator()(int mw, int nw, ACC& acc) const {
    const int lr = threadIdx.x & 31, hh = (threadIdx.x & 63) >> 5;
#pragma unroll
    for (int i = 0; i < 2; ++i)
#pragma unroll
      for (int j = 0; j < 2; ++j)
#pragma unroll
        for (int r = 0; r < 16; ++r) {
          size_t idx = (size_t)(mw + 32 * i + crow(r, hh)) * 1024 + nw + 32 * j + lr;
          X[idx] = ALPHA * R[idx] + acc[i][j][r];
        }
  }
};
template <int TRANS, class F>
DI void stage_tile(f32x16 (&acc)[2][2], u16* sT, F&& f) {
  const int tid = threadIdx.x, lane = tid & 63, wave = tid >> 6, wm = wave >> 1, wn = wave & 1, lr = lane & 31, hh = lane >> 5;
#pragma unroll
  for (int i = 0; i < 2; ++i)
#pragma unroll
    for (int j = 0; j < 2; ++j)
#pragma unroll
      for (int r = 0; r < 16; ++r) {
        const int row = wm * 64 + 32 * i + crow(r, hh), col = wn * 64 + 32 * j + lr;
        sT[TRANS ? col * 136 + row : row * 136 + col] = f2bf(acc[i][j][r]);
      }
  __syncthreads();
#pragma unroll
  for (int q = 0; q < 8; ++q) {
    const int c = tid + 256 * q; const int rr = c >> 4, cc = (c & 15) * 8;
    f(rr, cc, *(const u32x4*)(sT + rr * 136 + cc));
  }
}
struct EpiBf16 {
  u16* C; int ldc; u16* sT;
  template <class ACC> DI void operator()(int mw, int nw, ACC& acc) const {
    const int wave = threadIdx.x >> 6;
    const int m0 = mw - (wave >> 1) * 64, n0 = nw - (wave & 1) * 64;
    u16* Cp = C; const int ld = ldc;
    stage_tile<0>(acc, sT, [&](int rr, int cc, const u32x4& v) __attribute__((always_inline)) { *(u32x4*)(Cp + (size_t)(m0 + rr) * ld + n0 + cc) = v; });
  }
};

template <class Epi>
DI void gemm_phase22(const u16* A, int lda, const u16* A2, int lda2, int ksplit, const u16* Bt, int ldb, int K, int Mrows, int Ncols,
                     u16* smem, Epi&& epi, int bid, int nb) {
  const int ntn = Ncols / 128, ntm = Mrows / 128;
  if ((ntm & 63) == 0 && (nb & 7) == 0) {
    const int xcd = bid & 7, local = bid >> 3, nlocal = nb >> 3, mper = ntm >> 3;
    for (int idx = local; idx < mper * ntn; idx += nlocal) {
      const int sm = idx / (8 * ntn), rem = idx - sm * 8 * ntn, tn = rem >> 3, tmi = rem & 7;
      gemm_tile<2, 2>(A, lda, A2, lda2, ksplit, Bt, ldb, K, (xcd * mper + sm * 8 + tmi) * 128, tn * 128, smem, epi);
    }
  } else {
    for (int t = bid; t < ntm * ntn; t += nb) gemm_tile<2, 2>(A, lda, A2, lda2, ksplit, Bt, ldb, K, (t / ntn) * 128, (t % ntn) * 128, smem, epi);
  }
}

DI void xattn_ffn(const Params& p, int layer, const GridBar& grid, u16* smem, int bid, int nb, bool conv_mem_kv) {
  char* ws = p.ws;
  float* X = p.out;
  u16* XB = (u16*)(ws + OFF_XB);
  const char* lw = ws + OFF_LW + LW_STRIDE * layer;
  const u16* WQ = (const u16*)(lw + LW_WQ); const u16* WKV = (const u16*)(lw + LW_WKV); const u16* WO = (const u16*)(lw + LW_WO);
  const u16* W13 = (const u16*)(lw + LW_W13); const u16* W2F = (const u16*)(lw + LW_W2F);
  u16* Q = (u16*)(ws + OFF_S0); u16* Pm = (u16*)(ws + OFF_S1); u16* O = (u16*)(ws + OFF_S2); u16* H = (u16*)(ws + OFF_S0);
  u16* XAK = (u16*)(ws + OFF_XAK) + (size_t)layer * 1024 * 1024;
  u16* XAVT = (u16*)(ws + OFF_XAVT) + (size_t)layer * 1024 * 1024;
  const u16* MEMB = (const u16*)(ws + OFF_MEMB);
  const int tid = threadIdx.x, lane = tid & 63, lr = lane & 31, hh = lane >> 5;
  gemm_phase22(XB, 1024, XB, 1024, 1024, WQ, 1024, 1024, M_, 1024, smem, EpiBf16{Q, 1024, smem}, bid, nb);
  {
    auto epi = [&](int mw, int nw, f32x16 (&acc)[2][2]) __attribute__((always_inline)) {
      const int wv = tid >> 6;
      const int m0 = mw - (wv >> 1) * 64, n0 = nw - (wv & 1) * 64;
      if (n0 < 1024) {
        stage_tile<0>(acc, smem, [&](int rr, int cc, const u32x4& v) __attribute__((always_inline)) { *(u32x4*)(XAK + (size_t)(m0 + rr) * 1024 + n0 + cc) = v; });
      } else {
        stage_tile<1>(acc, smem, [&](int rr, int cc, const u32x4& v) __attribute__((always_inline)) {
          const int c = n0 - 1024 + rr, m = m0 + cc;
          *(u32x4*)(XAVT + ((size_t)((m >> 8) * 1024 + c)) * 256 + (m & 255)) = v;
        });
      }
    };
    gemm_phase22(MEMB, 1024, MEMB, 1024, 1024, WKV, 1024, 1024, 1024, 2048, smem, epi, (bid + nb / 2) % nb, nb);
  }
  grid.sync();
  {
    float* sred = (float*)(smem + 35840);
    u16* sP = smem;
    u16* sV = smem + 17408;
    for (int t = bid; t < 16 * 64; t += nb) {
      const int tid = FRESH_TID(), lane = tid & 63, lr = lane & 31, hh = lane >> 5, wave = tid >> 6, wm = wave >> 1, wn = wave & 1;
      const int bh = t >> 6, tm = t & 63, b = bh >> 2, h = bh & 3;
      const u16* Ab = Q + (size_t)b * 4096 * 1024 + h * 256;
      const u16* Bb = XAK + (size_t)b * 256 * 1024 + h * 256;
      const u16* Vb = XAVT + (size_t)bh * 256 * 256;
      u16* Ob = O + (size_t)b * 4096 * 1024 + h * 256;
      auto epi = [&](int mw, int nw, f32x16 (&acc)[1][4]) __attribute__((always_inline)) {
        float mx[16];
#pragma unroll
        for (int r = 0; r < 16; ++r) {
          float v = -1e30f;
#pragma unroll
          for (int j = 0; j < 4; ++j) { acc[0][j][r] *= 0.0625f; v = fmaxf(v, acc[0][j][r]); }
#pragma unroll
          for (int o = 16; o > 0; o >>= 1) v = fmaxf(v, __shfl_xor(v, o));
          mx[r] = v;
        }
        const int rbase = mw - tm * 64;
        if (lr == 0) {
#pragma unroll
          for (int r = 0; r < 16; ++r) sred[wn * 64 + rbase + crow(r, hh)] = mx[r];
        }
        __syncthreads();
        float sm[16];
#pragma unroll
        for (int r = 0; r < 16; ++r) {
          const int row = rbase + crow(r, hh);
          const float m2 = fmaxf(sred[row], sred[64 + row]);
          float s = 0.f;
#pragma unroll
          for (int j = 0; j < 4; ++j) { float e = __expf(acc[0][j][r] - m2); acc[0][j][r] = e; s += e; }
#pragma unroll
          for (int o = 16; o > 0; o >>= 1) s += __shfl_xor(s, o);
          sm[r] = s;
        }
        if (lr == 0) {
#pragma unroll
          for (int r = 0; r < 16; ++r) sred[128 + wn * 64 + rbase + crow(r, hh)] = sm[r];
        }
        __syncthreads();
#pragma unroll
        for (int r = 0; r < 16; ++r) {
          const int row = rbase + crow(r, hh);
          const float inv = __builtin_amdgcn_rcpf(sred[128 + row] + sred[192 + row]);
#pragma unroll
          for (int j = 0; j < 4; ++j) sP[row * 264 + nw + 32 * j + lr] = f2bf(acc[0][j][r] * inv);
        }
        __builtin_amdgcn_sched_barrier(0);
        u32x4 vr[8];
#pragma unroll
        for (int i = 0; i < 8; ++i) { const int c = tid + 256 * i; vr[i] = *(const u32x4*)(Vb + (size_t)(c >> 3) * 256 + (c & 7) * 8); }
        f32x16 o2[4];
#pragma unroll
        for (int j = 0; j < 4; ++j)
#pragma unroll
          for (int r = 0; r < 16; ++r) o2[j][r] = 0.f;
#pragma unroll 1
        for (int kt = 0; kt < 4; ++kt) {
          __syncthreads();
#pragma unroll
          for (int i = 0; i < 8; ++i) { const int c = tid + 256 * i; *(u32x4*)(sV + (c >> 3) * 72 + (c & 7) * 8) = vr[i]; }
          if (kt + 1 < 4) {
#pragma unroll
            for (int i = 0; i < 8; ++i) { const int c = tid + 256 * i; vr[i] = *(const u32x4*)(Vb + (size_t)(c >> 3) * 256 + (kt + 1) * 64 + (c & 7) * 8); }
          }
          __syncthreads();
#pragma unroll
          for (int ks = 0; ks < 4; ++ks) {
            const bf16x8 af = *(const bf16x8*)(sP + (wm * 32 + lr) * 264 + kt * 64 + ks * 16 + hh * 8);
#pragma unroll
            for (int j = 0; j < 4; ++j) {
              const bf16x8 bfr = *(const bf16x8*)(sV + (wn * 128 + 32 * j + lr) * 72 + ks * 16 + hh * 8);
              o2[j] = MFMA(af, bfr, o2[j]);
            }
          }
        }
        __syncthreads();
#pragma unroll
        for (int j = 0; j < 4; ++j)
#pragma unroll
          for (int r = 0; r < 16; ++r) sP[(rbase + crow(r, hh)) * 264 + wn * 128 + 32 * j + lr] = f2bf(o2[j][r]);
        __syncthreads();
#pragma unroll
        for (int q = 0; q < 8; ++q) {
          const int c = tid + 256 * q; const int rr = c >> 5, cc = (c & 31) * 8;
          *(u32x4*)(Ob + (size_t)(tm * 64 + rr) * 1024 + cc) = *(const u32x4*)(sP + rr * 264 + cc);
        }
      };
      gemm_tile<1, 4>(Ab, 1024, Ab, 1024, 256, Bb, 1024, 256, tm * 64, 0, smem, epi);
    }
  }
  grid.sync();
  gemm_phase22(O, 1024, O, 1024, 1024, WO, 1024, 1024, M_, 1024, smem, EpiResid{X, X}, bid, nb);
  grid.sync();
  ln_phase(X, p.in[28] + layer * 1024, p.in[29] + layer * 1024, XB, bid, nb);
  grid.sync();
  {
    auto epi = [&](int mw, int nw, f32x16 (&acc)[2][2]) __attribute__((always_inline)) {
      const int wv = tid >> 6, wm_ = wv >> 1, wn_ = wv & 1;
      const int m0 = mw - wm_ * 64, n0 = nw - wn_ * 64;
      u16* sT = smem;
#pragma unroll
      for (int i = 0; i < 2; ++i)
#pragma unroll
        for (int r = 0; r < 16; ++r) {
          const float g = acc[i][0][r], u = acc[i][1][r];
          sT[(wm_ * 64 + 32 * i + crow(r, hh)) * 72 + wn_ * 32 + lr] = f2bf(siluf_(g) * u);
        }
      __syncthreads();
#pragma unroll
      for (int q = 0; q < 4; ++q) {
        const int c = tid + 256 * q; const int rr = c >> 3, cc = (c & 7) * 8;
        *(u32x4*)(H + (size_t)(m0 + rr) * FFN_H + (n0 >> 1) + cc) = *(const u32x4*)(sT + rr * 72 + cc);
      }
    };
    for (int rpt = 0; rpt < RPT_FFN; ++rpt)
    gemm_phase22(XB, 1024, XB, 1024, 1024, W13, 1024, 1024, M_, 2 * FFN_H, smem, epi, bid, nb);
  }
  grid.sync();
  gemm_phase22(H, FFN_H, H, FFN_H, FFN_H, W2F, FFN_H, FFN_H, M_, 1024, smem, EpiResid{X, X}, bid, nb);
  grid.sync();
  ln_phase(X, p.in[32] + layer * 1024, p.in[33] + layer * 1024, XB, bid, nb);
  if (layer == 0) grid.sync();
}

__global__ void __launch_bounds__(256, 2) fwd_megakernel(Params p) {
  __shared__ __attribute__((aligned(16))) char smem_raw[72 * 1024];
  __shared__ uint4 xb_words;
  if (p.ws == nullptr) cg::this_grid().sync();
  if (threadIdx.x == 0) xb_words = make_uint4(0u, 0u, 0u, 0u);
  __syncthreads();
  GridBar grid;
  grid.b = xcd_barrier_post((unsigned*)(p.ws + OFF_BAR), (volatile LAS unsigned*)&xb_words);
  u16* smem = (u16*)smem_raw;
  float* smf = (float*)smem_raw;
  const int bid = blockIdx.x, nb = gridDim.x, tid = threadIdx.x, lane = tid & 63, wave = tid >> 6, lr = lane & 31, hh = lane >> 5;
  char* ws = p.ws;
  char* dout = (char*)p.out;
  u16* RW = (u16*)(ws + OFF_RW); u16* XBC = (u16*)(ws + OFF_XBC); u16* Z = (u16*)(ws + OFF_Z);
  u16* WIN = (u16*)(ws + OFF_WIN); u16* WOUT = (u16*)(ws + OFF_WOUT); u16* XB = (u16*)(ws + OFF_XB);
  float* DT = (float*)(ws + OFF_DT); u16* LIN = (u16*)(ws + OFF_LIN); u16* MEMB = (u16*)(ws + OFF_MEMB);
  float* KMEAN = (float*)(ws + OFF_KMEAN); float* CDEC = (float*)(ws + OFF_CDEC);
  u16* W2T = (u16*)(ws + OFF_LORAW); u16* A2T = W2T + 1024 * 64; u16* G2T = A2T + 1024 * 64;
  u16* XT = (u16*)(dout + DO_XT); u16* BM = (u16*)(dout + DO_BM); u16* BMT = (u16*)(dout + DO_BMT); u16* CM = (u16*)(dout + DO_CM);
  u16* WE = (u16*)(dout + DO_WE); u16* AA = (u16*)(dout + DO_AA);
  u16* STATES = (u16*)(ws + OFF_STATES); u16* GG = (u16*)(ws + OFF_GG); u16* YR = (u16*)(ws + OFF_YR);

  conv_weight(p.in[2], 1024, EVEN_IN, EVEN_IN_PAD, WIN, 0, smf, bid, nb);
  conv_weight(p.in[20], 2048, 1024, 1024, WOUT, 0, smf, bid, nb);
  conv_weight(p.in[11], 64, 1024, 1024, W2T, 0, smf, bid, nb);
  conv_weight(p.in[13], 64, 1024, 1024, A2T, 0, smf, bid, nb);
  conv_weight(p.in[14], 128, 1024, 1024, G2T, 0, smf, bid, nb);
  conv_act(p.in[0], XB, (size_t)M_ * 1024, bid, nb);
  conv_act(p.in[1], MEMB, (size_t)1024 * 1024, bid, nb);
  grid.sync();

  {
    const float* dtb = p.in[5];
    auto epi = [&](int mw, int nw, f32x16 (&acc)[2][2]) __attribute__((always_inline)) {
      const int wv = tid >> 6;
      const int m0 = mw - (wv >> 1) * 64, n0 = nw - (wv & 1) * 64;
      if (nw == 2560 && lr < 16) {
#pragma unroll
        for (int i = 0; i < 2; ++i)
#pragma unroll
          for (int r = 0; r < 16; ++r) DT[(size_t)(mw + 32 * i + crow(r, hh)) * 16 + lr] = softplusf_(acc[i][0][r] + dtb[lr]);
      }
      stage_tile<0>(acc, smem, [&](int rr, int cc, const u32x4& v) __attribute__((always_inline)) {
        const int n = n0 + cc; const size_t m = m0 + rr;
        if (n < 1024) *(u32x4*)(Z + m * 1024 + n) = v;
        else if (n < 2560) *(u32x4*)(XBC + m * 1536 + (n - 1024)) = v;
        else if (n < 2576) { }
        else if (n < EVEN_IN) *(u32x4*)(RW + m * 3328 + (n - 2576)) = v;
      });
    };
    gemm_phase22(XB, 1024, XB, 1024, 1024, WIN, 1024, 1024, M_, EVEN_IN_PAD, smem, epi, bid, nb);
  }
  grid.sync();

  {
    const float* cw = p.in[3]; const float* cb = p.in[4];
    u16* sT = smem;
    for (int t = bid; t < 256 * 24; t += nb) {
      const int tt = t / 24, ct = t % 24;
      const int tok = tid >> 2, cq = tid & 3;
      const int gt = tt * 64 + tok, s = gt & 4095;
      const int c0 = ct * 64 + cq * 16;
      float accv[16];
#pragma unroll
      for (int q = 0; q < 16; ++q) accv[q] = cb[c0 + q];
      u32x4 xv[4][2];
#pragma unroll
      for (int k = 0; k < 4; ++k) {
        const int kk = (s - 3 + k >= 0) ? k : 3;
        const u16* src = XBC + (size_t)(gt - 3 + kk) * 1536 + c0;
        xv[k][0] = *(const u32x4*)src; xv[k][1] = *(const u32x4*)(src + 8);
      }
#pragma unroll
      for (int k = 0; k < 4; ++k) {
        float f[16];
        unpack8(xv[k][0], f); unpack8(xv[k][1], f + 8);
        const float msk = (s - 3 + k >= 0) ? 1.f : 0.f;
#pragma unroll
        for (int q = 0; q < 16; ++q) accv[q] += cw[k * 1536 + c0 + q] * (f[q] * msk);
      }
#pragma unroll
      for (int q = 0; q < 16; ++q) accv[q] = siluf_(accv[q]);
      const bool transposed = (ct < 20);
      if (ct >= 16) {
        u16* dst = (ct < 20 ? BM : CM) + (size_t)gt * 256 + ((ct - 16) & 3) * 64 + cq * 16;
        *(uint4*)dst = pack8(accv); *(uint4*)(dst + 8) = pack8(accv + 8);
      }
      if (transposed) {
        __syncthreads();
#pragma unroll
        for (int q = 0; q < 16; ++q) sT[(cq * 16 + q) * 72 + tok] = f2bf(accv[q]);
        __syncthreads();
        const int ch = tid >> 2, tq = tid & 3;
        const int b = tt >> 6, s0 = (tt & 63) * 64;
        u16* dst;
        if (ct < 16) dst = XT + ((size_t)((b * 16 + ct) * 64 + ch)) * 4096 + s0 + tq * 16;
        else dst = BMT + ((size_t)(b * 256 + (ct - 16) * 64 + ch)) * 4096 + s0 + tq * 16;
        *(uint4*)dst = *(const uint4*)(sT + ch * 72 + tq * 16);
        *(uint4*)(dst + 8) = *(const uint4*)(sT + ch * 72 + tq * 16 + 8);
      }
    }
    const float* mu = p.in[9];
    for (int i = bid * 256 + tid; i < M_ * 32; i += nb * 256) {
      const int gt = i >> 5, c8 = (i & 31) * 8, s = gt & 4095;
      const u16* cur = RW + (size_t)gt * 3328 + 3072 + c8;
      float fc[8], fp[8];
      unpack8(*(const uint4*)cur, fc);
      if (s > 0) unpack8(*(const uint4*)(cur - 3328), fp);
      else {
#pragma unroll
        for (int q = 0; q < 8; ++q) fp[q] = 0.f;
      }
      float o[8];
#pragma unroll
      for (int q = 0; q < 8; ++q) {
        float v = fc[q] + (fp[q] - fc[q]) * mu[3072 + c8 + q];
        o[q] = (c8 < 64) ? tanhf(v) : ((c8 < 128) ? v : sigmoidf_(v));
      }
      *(uint4*)(LIN + (size_t)gt * 256 + c8) = pack8(o);
    }
  }
  grid.sync();

  {
    u16* sBt = smem;
    u16* sX = smem + 128 * 136;
    float* sac = (float*)(smem + 192 * 136);
    float* ssc = sac + 128;
    const float* alog = p.in[6];
    const int lrow = tid >> 4, lcol = (tid & 15) * 8;
    for (int t = bid; t < 512; t += nb) {
      const int b = t >> 7, c = (t >> 2) & 31, g = (t >> 1) & 1, half = t & 1;
      const int tok0 = b * 4096 + c * 128;
      u32x4 bt[8];
#pragma unroll
      for (int i = 0; i < 8; ++i) bt[i] = *(const u32x4*)(BMT + ((size_t)((b * 2 + g) * 128 + lrow + 16 * i)) * 4096 + c * 128 + lcol);
      __syncthreads();
#pragma unroll
      for (int i = 0; i < 8; ++i) *(u32x4*)(sBt + (lrow + 16 * i) * 136 + lcol) = bt[i];
      for (int hq = 0; hq < 4; ++hq) {
        const int h = g * 8 + half * 4 + hq;
        const int ti = (b * 32 + c) * 16 + h;
        const float aneg = -__expf(alog[h]);
        u32x4 xv[4];
#pragma unroll
        for (int i = 0; i < 4; ++i) xv[i] = *(const u32x4*)(XT + ((size_t)((b * 16 + h) * 64 + lrow + 16 * i)) * 4096 + c * 128 + lcol);
        float dtv = 0.f;
        if (tid < 128) dtv = DT[(size_t)(tok0 + tid) * 16 + h];
        __syncthreads();
        if (tid < 128) sac[tid] = dtv * aneg;
        block_cumsum128(sac);
        const float alast = sac[127];
        if (tid < 128) ssc[tid] = dtv * __expf(alast - sac[tid]);
        if (tid == 0) CDEC[ti] = __expf(alast);
        __syncthreads();
        {
          const float4 s0 = *(const float4*)(ssc + lcol), s1 = *(const float4*)(ssc + lcol + 4);
#pragma unroll
          for (int i = 0; i < 4; ++i) {
            float f[8];
            unpack8(xv[i], f);
            f[0] *= s0.x; f[1] *= s0.y; f[2] *= s0.z; f[3] *= s0.w; f[4] *= s1.x; f[5] *= s1.y; f[6] *= s1.z; f[7] *= s1.w;
            *(uint4*)(sX + (lrow + 16 * i) * 136 + lcol) = pack8(f);
          }
        }
        __syncthreads();
        f32x16 acc[2];
#pragma unroll
        for (int r = 0; r < 16; ++r) { acc[0][r] = 0.f; acc[1][r] = 0.f; }
#pragma unroll
        for (int ks = 0; ks < 8; ++ks) {
          const bf16x8 bf = *(const bf16x8*)(sBt + (32 * wave + lr) * 136 + 16 * ks + 8 * hh);
#pragma unroll
          for (int pt = 0; pt < 2; ++pt) {
            const bf16x8 af = *(const bf16x8*)(sX + (32 * pt + lr) * 136 + 16 * ks + 8 * hh);
            acc[pt] = MFMA(af, bf, acc[pt]);
          }
        }
        u16* dst = STATES + (size_t)ti * 8192;
#pragma unroll
        for (int pt = 0; pt < 2; ++pt)
#pragma unroll
          for (int r = 0; r < 16; ++r) dst[(32 * pt + crow(r, hh)) * 128 + 32 * wave + lr] = f2bf(acc[pt][r]);
      }
    }
  }
  grid.sync();

  for (int gt = bid * 256 + tid; gt < 131072; gt += nb * 256) {
    const int bhh = gt >> 11, e = (gt & 2047) * 4, b = bhh >> 4, h = bhh & 15;
    float carry[4];
#pragma unroll
    for (int q = 0; q < 4; ++q) carry[q] = 0.f;
    for (int cb8 = 0; cb8 < 32; cb8 += 8) {
      uint2 sv8[8]; float dec8[8];
#pragma unroll
      for (int i = 0; i < 8; ++i) {
        const int ti = (b * 32 + cb8 + i) * 16 + h;
        sv8[i] = *(const uint2*)(STATES + (size_t)ti * 8192 + e);
        dec8[i] = CDEC[ti];
      }
#pragma unroll
      for (int i = 0; i < 8; ++i) {
        const int ti = (b * 32 + cb8 + i) * 16 + h;
        const float s0 = blo(sv8[i].x), s1 = bhi(sv8[i].x), s2 = blo(sv8[i].y), s3 = bhi(sv8[i].y);
        uint2 o; o.x = pk2(carry[0], carry[1]); o.y = pk2(carry[2], carry[3]);
        *(uint2*)(STATES + (size_t)ti * 8192 + e) = o;
        carry[0] = carry[0] * dec8[i] + s0; carry[1] = carry[1] * dec8[i] + s1;
        carry[2] = carry[2] * dec8[i] + s2; carry[3] = carry[3] * dec8[i] + s3;
      }
    }
  }
  grid.sync();

  {
    u16* sB = smem;
    u16* sC = smem + 128 * 136;
    u16* sX = smem + 128 * 136;
    u16* sS = smem + 192 * 136;
    float* sac = (float*)(smem + 256 * 136);
    float* sdt = sac + 128;
    const float* alog = p.in[6]; const float* dsk = p.in[7];
    const int lrow = tid >> 4, lcol = (tid & 15) * 8;
    const int w = wave, l = 32 * w + lr;
    for (int t = bid; t < 512; t += nb) {
      const int b = t >> 7, c = (t >> 2) & 31, g = (t >> 1) & 1, half = t & 1;
      const int tok0 = b * 4096 + c * 128;
      {
        u32x4 bv[8], cv[8];
#pragma unroll
        for (int i = 0; i < 8; ++i) {
          bv[i] = *(const u32x4*)(BM + (size_t)(tok0 + lrow + 16 * i) * 256 + g * 128 + lcol);
          cv[i] = *(const u32x4*)(CM + (size_t)(tok0 + lrow + 16 * i) * 256 + g * 128 + lcol);
        }
        __syncthreads();
#pragma unroll
        for (int i = 0; i < 8; ++i) {
          *(u32x4*)(sB + (lrow + 16 * i) * 136 + lcol) = bv[i];
          *(u32x4*)(sC + (lrow + 16 * i) * 136 + lcol) = cv[i];
        }
        __syncthreads();
      }
      bf16x8 qf[8];
#pragma unroll
      for (int ks = 0; ks < 8; ++ks) qf[ks] = *(const bf16x8*)(sC + l * 136 + 16 * ks + 8 * hh);
#pragma unroll 1
      for (int hq = 0; hq < 4; ++hq) {
        const int h = g * 8 + half * 4 + hq;
        const int ti = (b * 32 + c) * 16 + h;
        const float aneg = -__expf(alog[h]);
        const float dskip = dsk[h];
        u32x4 xv[4], sv[4];
#pragma unroll
        for (int i = 0; i < 4; ++i) {
          xv[i] = *(const u32x4*)(XT + ((size_t)((b * 16 + h) * 64 + lrow + 16 * i)) * 4096 + c * 128 + lcol);
          sv[i] = *(const u32x4*)(STATES + (size_t)ti * 8192 + (lrow + 16 * i) * 128 + lcol);
        }
        float dtv = 0.f;
        if (tid < 128) dtv = DT[(size_t)(tok0 + tid) * 16 + h];
        __syncthreads();
#pragma unroll
        for (int i = 0; i < 4; ++i) {
          *(u32x4*)(sX + (lrow + 16 * i) * 136 + lcol) = xv[i];
          *(u32x4*)(sS + (lrow + 16 * i) * 136 + lcol) = sv[i];
        }
        if (tid < 128) { sdt[tid] = dtv; sac[tid] = dtv * aneg; }
        block_cumsum128(sac);
        const float al = sac[l];
        const float eal = __expf(al);
        uint2 zv[2][4];
#pragma unroll
        for (int pt = 0; pt < 2; ++pt)
#pragma unroll
          for (int q4 = 0; q4 < 4; ++q4) zv[pt][q4] = *(const uint2*)(Z + (size_t)(tok0 + l) * 1024 + h * 64 + 32 * pt + 8 * q4 + 4 * hh);
        f32x16 O[2];
#pragma unroll
        for (int r = 0; r < 16; ++r) { O[0][r] = 0.f; O[1][r] = 0.f; }
#pragma unroll
        for (int ks = 0; ks < 8; ++ks)
#pragma unroll
          for (int pt = 0; pt < 2; ++pt) O[pt] = MFMA(*(const bf16x8*)(sS + (32 * pt + lr) * 136 + 16 * ks + 8 * hh), qf[ks], O[pt]);
#pragma unroll
        for (int r = 0; r < 16; ++r) { O[0][r] *= eal; O[1][r] *= eal; }
#pragma unroll 1
        for (int st = 0; st < 4; ++st) {
          if (st <= w) {
            f32x16 Sx;
#pragma unroll
            for (int r = 0; r < 16; ++r) Sx[r] = 0.f;
#pragma unroll
            for (int ks = 0; ks < 8; ++ks) Sx = MFMA(*(const bf16x8*)(sB + (32 * st + lr) * 136 + 16 * ks + 8 * hh), qf[ks], Sx);
#pragma unroll
            for (int r = 0; r < 16; ++r) {
              const int s = 32 * st + crow(r, hh);
              float v = (s <= l) ? Sx[r] * __expf(al - sac[s]) * sdt[s] : 0.f;
              if (s == l) v += dskip;
              Sx[r] = v;
            }
#pragma unroll
            for (int s2 = 0; s2 < 2; ++s2) {
              bf16x8 pf = pack_frag(Sx, s2);
#pragma unroll
              for (int pt = 0; pt < 2; ++pt) O[pt] = MFMA(ld_frag8x2(sX + (32 * pt + lr) * 136 + 32 * st + 16 * s2 + 4 * hh), pf, O[pt]);
            }
          }
        }
#pragma unroll
        for (int pt = 0; pt < 2; ++pt)
#pragma unroll
          for (int q4 = 0; q4 < 4; ++q4) {
            u16* zp = Z + (size_t)(tok0 + l) * 1024 + h * 64 + 32 * pt + 8 * q4 + 4 * hh;
            const uint2 zz = zv[pt][q4];
            float y0 = O[pt][4 * q4 + 0] * siluf_(blo(zz.x));
            float y1 = O[pt][4 * q4 + 1] * siluf_(bhi(zz.x));
            float y2 = O[pt][4 * q4 + 2] * siluf_(blo(zz.y));
            float y3 = O[pt][4 * q4 + 3] * siluf_(bhi(zz.y));
            uint2 o; o.x = pk2(y0, y1); o.y = pk2(y2, y3);
            *(uint2*)zp = o;
          }
      }
    }
  }
  grid.sync();

  {
    const float* w0 = p.in[10]; const float* a0 = p.in[12];
    auto epiw = [&](int mw, int nw, f32x16 (&acc)[2][2]) __attribute__((always_inline)) {
#pragma unroll
      for (int i = 0; i < 2; ++i)
#pragma unroll
        for (int j = 0; j < 2; ++j) {
          const int n = nw + 32 * j + lr; const float w0n = w0[n];
#pragma unroll
          for (int r = 0; r < 16; ++r) {
            float wr = -softplusf_(-(w0n + acc[i][j][r])) - 0.5f;
            WE[(size_t)(mw + 32 * i + crow(r, hh)) * 1024 + n] = f2bf(__expf(wr));
          }
        }
    };
    auto epia = [&](int mw, int nw, f32x16 (&acc)[2][2]) __attribute__((always_inline)) {
#pragma unroll
      for (int i = 0; i < 2; ++i)
#pragma unroll
        for (int j = 0; j < 2; ++j) {
          const int n = nw + 32 * j + lr; const float a0n = a0[n];
#pragma unroll
          for (int r = 0; r < 16; ++r) AA[(size_t)(mw + 32 * i + crow(r, hh)) * 1024 + n] = f2bf(sigmoidf_(a0n + acc[i][j][r]));
        }
    };
    gemm_phase22(LIN, 256, LIN, 256, 64, W2T, 64, 64, M_, 1024, smem, epiw, bid, nb);
    gemm_phase22(LIN + 64, 256, LIN + 64, 256, 64, A2T, 64, 64, M_, 1024, smem, epia, bid, nb);
    gemm_phase22(LIN + 128, 256, LIN + 128, 256, 128, G2T, 128, 128, M_, 1024, smem, EpiBf16{GG, 1024, smem}, bid, nb);
  }
  grid.sync();

  {
    float* sr = smf; float* sw = sr + 2048; float* sk = sw + 2048; float* sa = sk + 2048; float* sb = sa + 2048;
    float* sv = sb + 2048;
    float* sy = sv + 512;
    const float* mu = p.in[9]; const float* kkp = p.in[15]; const float* kap = p.in[16];
    for (int rpt = 0; rpt < RPT_SCAN; ++rpt)
    for (int task = bid; task < 256; task += nb) {
      const int bhh = task >> 2, rq = task & 3, b = bhh >> 4, h = bhh & 15;
      const int pt_ = tid >> 3, jg = tid & 7, ch = h * 64 + 8 * jg;
      float mur[8], muk[8], muv[8], kkw[8], kaw[8];
#pragma unroll
      for (int q = 0; q < 8; ++q) { mur[q] = mu[ch + q]; muk[q] = mu[1024 + ch + q]; muv[q] = mu[2048 + ch + q]; kkw[q] = kkp[ch + q]; kaw[q] = kap[ch + q]; }
      const int row = tid >> 4, jq = tid & 15;
      float S0 = 0.f, S1 = 0.f, S2 = 0.f, S3 = 0.f;
      u32x4 gr, gk, gv, gpr, gpk, gpv, gwe, gaa;
#define ISSUE(tc_) { \
        const int s = (tc_) * 32 + pt_; \
        const size_t gt = (size_t)b * 4096 + s; \
        const u16* cur = RW + gt * 3328 + ch; \
        gr = *(const u32x4*)cur; gk = *(const u32x4*)(cur + 1024); gv = *(const u32x4*)(cur + 2048); \
        if (s > 0) { gpr = *(const u32x4*)(cur - 3328); gpk = *(const u32x4*)(cur - 3328 + 1024); gpv = *(const u32x4*)(cur - 3328 + 2048); } \
        else { gpr = (u32x4){0u, 0u, 0u, 0u}; gpk = gpr; gpv = gpr; } \
        gwe = *(const u32x4*)(WE + gt * 1024 + ch); gaa = *(const u32x4*)(AA + gt * 1024 + ch); }
      ISSUE(0);
      for (int tc = 0; tc < 128; ++tc) {
        __syncthreads();
        {
          float r[8], k[8], v[8], pr[8], pk[8], pv[8], we[8], aa[8];
          unpack8(gr, r); unpack8(gk, k); unpack8(gv, v); unpack8(gpr, pr); unpack8(gpk, pk); unpack8(gpv, pv); unpack8(gwe, we); unpack8(gaa, aa);
          float kk[8], ss = 0.f;
#pragma unroll
          for (int q = 0; q < 8; ++q) {
            r[q] += (pr[q] - r[q]) * mur[q]; k[q] += (pk[q] - k[q]) * muk[q]; v[q] += (pv[q] - v[q]) * muv[q];
            kk[q] = k[q] * kkw[q]; ss += kk[q] * kk[q];
          }
          ss += __shfl_xor(ss, 1); ss += __shfl_xor(ss, 2); ss += __shfl_xor(ss, 4);
          const float inv = rsqrtf(fmaxf(ss, 1e-24f));
          float o_w[8], o_k[8], o_a[8], o_b[8];
#pragma unroll
          for (int q = 0; q < 8; ++q) {
            kk[q] *= inv;
            o_w[q] = __expf(-we[q]);
            o_k[q] = k[q] * (1.f + (aa[q] - 1.f) * kaw[q]);
            o_a[q] = -kk[q]; o_b[q] = kk[q] * aa[q];
          }
          const int o = pt_ * 64 + 8 * jg;
          *(float4*)(sr + o) = make_float4(r[0], r[1], r[2], r[3]); *(float4*)(sr + o + 4) = make_float4(r[4], r[5], r[6], r[7]);
          *(float4*)(sw + o) = make_float4(o_w[0], o_w[1], o_w[2], o_w[3]); *(float4*)(sw + o + 4) = make_float4(o_w[4], o_w[5], o_w[6], o_w[7]);
          *(float4*)(sk + o) = make_float4(o_k[0], o_k[1], o_k[2], o_k[3]); *(float4*)(sk + o + 4) = make_float4(o_k[4], o_k[5], o_k[6], o_k[7]);
          *(float4*)(sa + o) = make_float4(o_a[0], o_a[1], o_a[2], o_a[3]); *(float4*)(sa + o + 4) = make_float4(o_a[4], o_a[5], o_a[6], o_a[7]);
          *(float4*)(sb + o) = make_float4(o_b[0], o_b[1], o_b[2], o_b[3]); *(float4*)(sb + o + 4) = make_float4(o_b[4], o_b[5], o_b[6], o_b[7]);
          if ((jg >> 1) == rq) {
            const int ov = pt_ * 16 + 8 * (jg & 1);
            *(float4*)(sv + ov) = make_float4(v[0], v[1], v[2], v[3]); *(float4*)(sv + ov + 4) = make_float4(v[4], v[5], v[6], v[7]);
          }
        }
        if (tc + 1 < 128) ISSUE(tc + 1);
        __syncthreads();
        {
          const int bit0 = jq & 1, bit1 = (jq >> 1) & 1;
#pragma unroll 2
          for (int t0 = 0; t0 < 32; t0 += 4) {
            float4 w4[4], k4[4], a4[4], b4[4], r4[4]; float vv[4];
#pragma unroll
            for (int u = 0; u < 4; ++u) {
              const int t = t0 + u;
              w4[u] = *(const float4*)(sw + t * 64 + 4 * jq);
              k4[u] = *(const float4*)(sk + t * 64 + 4 * jq);
              a4[u] = *(const float4*)(sa + t * 64 + 4 * jq);
              b4[u] = *(const float4*)(sb + t * 64 + 4 * jq);
              r4[u] = *(const float4*)(sr + t * 64 + 4 * jq);
              vv[u] = sv[t * 16 + row];
            }
            float yq[4];
#pragma unroll
            for (int u = 0; u < 4; ++u) {
              const float part = S0 * a4[u].x + S1 * a4[u].y + S2 * a4[u].z + S3 * a4[u].w;
              const float sa_ = row16_sum(part);
              S0 = S0 * w4[u].x + vv[u] * k4[u].x + sa_ * b4[u].x;
              S1 = S1 * w4[u].y + vv[u] * k4[u].y + sa_ * b4[u].y;
              S2 = S2 * w4[u].z + vv[u] * k4[u].z + sa_ * b4[u].z;
              S3 = S3 * w4[u].w + vv[u] * k4[u].w + sa_ * b4[u].w;
              yq[u] = S0 * r4[u].x + S1 * r4[u].y + S2 * r4[u].z + S3 * r4[u].w;
            }
            float u0 = bit0 ? yq[2] : yq[0], u1 = bit0 ? yq[3] : yq[1];
            const float s0 = bit0 ? yq[0] : yq[2], s1 = bit0 ? yq[1] : yq[3];
            u0 += dppf<0xB1>(s0); u1 += dppf<0xB1>(s1);
            float kq = bit1 ? u1 : u0; const float sq2 = bit1 ? u0 : u1;
            kq += dppf<0x4E>(sq2);
            kq += dppf<0x124>(kq);
            kq += dppf<0x128>(kq);
            if (jq < 4) sy[(t0 + 2 * bit0 + bit1) * 16 + row] = kq;
          }
        }
        __syncthreads();
        {
          const int t = tid >> 3, pr2 = tid & 7;
          const size_t gt = (size_t)b * 4096 + tc * 32 + t;
          *(unsigned*)(YR + gt * 1024 + h * 64 + 16 * rq + 2 * pr2) = pk2(sy[t * 16 + 2 * pr2], sy[t * 16 + 2 * pr2 + 1]);
        }
      }
    }
  }
  grid.sync();

  {
    const float* ng = p.in[8]; const float* mu = p.in[9]; const float* kap = p.in[16]; const float* rkp = p.in[17];
    const float* lg = p.in[18]; const float* lb = p.in[19];
    for (int tok = bid * 4 + wave; tok < M_; tok += nb * 4) {
      const int c0 = 16 * lane, s = tok & 4095;
      {
        u16* zp = Z + (size_t)tok * 1024 + c0;
        float y[16];
        unpack8(*(const uint4*)zp, y); unpack8(*(const uint4*)(zp + 8), y + 8);
        float ss = 0.f;
#pragma unroll
        for (int q = 0; q < 16; ++q) ss += y[q] * y[q];
#pragma unroll
        for (int o = 16; o > 0; o >>= 1) ss += __shfl_xor(ss, o);
        const float rs = rsqrtf(ss * (1.f / 512.f) + 1e-5f);
#pragma unroll
        for (int q = 0; q < 16; ++q) y[q] = y[q] * rs * ng[c0 + q];
        *(uint4*)zp = pack8(y); *(uint4*)(zp + 8) = pack8(y + 8);
      }
      {
        u16* yp = YR + (size_t)tok * 1024 + c0;
        float y[16], r[16], k[16], v[16], a[16], gg[16], tmp[16];
        unpack8(*(const uint4*)yp, y); unpack8(*(const uint4*)(yp + 8), y + 8);
        const u16* cur = RW + (size_t)tok * 3328 + c0;
        unpack8(*(const uint4*)cur, r); unpack8(*(const uint4*)(cur + 8), r + 8);
        unpack8(*(const uint4*)(cur + 1024), k); unpack8(*(const uint4*)(cur + 1032), k + 8);
        unpack8(*(const uint4*)(cur + 2048), v); unpack8(*(const uint4*)(cur + 2056), v + 8);
        if (s > 0) {
          const u16* prv = cur - 3328;
          unpack8(*(const uint4*)prv, tmp); unpack8(*(const uint4*)(prv + 8), tmp + 8);
#pragma unroll
          for (int q = 0; q < 16; ++q) r[q] += (tmp[q] - r[q]) * mu[c0 + q];
          unpack8(*(const uint4*)(prv + 1024), tmp); unpack8(*(const uint4*)(prv + 1032), tmp + 8);
#pragma unroll
          for (int q = 0; q < 16; ++q) k[q] += (tmp[q] - k[q]) * mu[1024 + c0 + q];
          unpack8(*(const uint4*)(prv + 2048), tmp); unpack8(*(const uint4*)(prv + 2056), tmp + 8);
#pragma unroll
          for (int q = 0; q < 16; ++q) v[q] += (tmp[q] - v[q]) * mu[2048 + c0 + q];
        } else {
#pragma unroll
          for (int q = 0; q < 16; ++q) { r[q] -= r[q] * mu[c0 + q]; k[q] -= k[q] * mu[1024 + c0 + q]; v[q] -= v[q] * mu[2048 + c0 + q]; }
        }
        const u16* ap = AA + (size_t)tok * 1024 + c0;
        unpack8(*(const uint4*)ap, a); unpack8(*(const uint4*)(ap + 8), a + 8);
        const u16* gp = GG + (size_t)tok * 1024 + c0;
        unpack8(*(const uint4*)gp, gg); unpack8(*(const uint4*)(gp + 8), gg + 8);
        float sm = 0.f, dot = 0.f;
#pragma unroll
        for (int q = 0; q < 16; ++q) {
          sm += y[q];
          const float k2 = k[q] * (1.f + (a[q] - 1.f) * kap[c0 + q]);
          dot += r[q] * k2 * rkp[c0 + q];
        }
        sm += __shfl_xor(sm, 1); sm += __shfl_xor(sm, 2);
        dot += __shfl_xor(dot, 1); dot += __shfl_xor(dot, 2);
        const float mean = sm * (1.f / 64.f);
        float vs = 0.f;
#pragma unroll
        for (int q = 0; q < 16; ++q) { const float d = y[q] - mean; vs += d * d; }
        vs += __shfl_xor(vs, 1); vs += __shfl_xor(vs, 2);
        const float rs = rsqrtf(vs * (1.f / 64.f) + 64e-5f);
#pragma unroll
        for (int q = 0; q < 16; ++q) y[q] = ((y[q] - mean) * rs * lg[c0 + q] + lb[c0 + q] + dot * v[q]) * gg[q];
        *(uint4*)yp = pack8(y); *(uint4*)(yp + 8) = pack8(y + 8);
      }
    }
  }
  grid.sync();

  gemm_phase22(Z, 1024, YR, 1024, 1024, WOUT, 2048, 2048, M_, 1024, smem, EpiResid{p.in[0], p.out}, bid, nb);
  grid.sync();

  ln_phase(p.out, p.in[23], p.in[24], XB, bid, nb);
  conv_weight(p.in[21], 1024, 3072, 3072, (u16*)(ws + OFF_QKV1), 0, smf, bid, nb);
  conv_weight(p.in[22], 1024, 1024, 1024, (u16*)(ws + OFF_OUT1), 0, smf, bid, nb);
  for (int l = 0; l < 2; ++l) {
    char* lw = ws + OFF_LW + LW_STRIDE * l;
    conv_weight(p.in[25] + (size_t)l * 1024 * 1024, 1024, 1024, 1024, (u16*)(lw + LW_WQ), 0, smf, bid, nb);
    conv_weight(p.in[26] + (size_t)l * 1024 * 2048, 1024, 2048, 2048, (u16*)(lw + LW_WKV), 0, smf, bid, nb);
    conv_weight(p.in[27] + (size_t)l * 1024 * 1024, 1024, 1024, 1024, (u16*)(lw + LW_WO), 0, smf, bid, nb);
    conv_weight(p.in[30] + (size_t)l * 1024 * 2 * FFN_H, 1024, 2 * FFN_H, 2 * FFN_H, (u16*)(lw + LW_W13), 1, smf, bid, nb);
    conv_weight(p.in[31] + (size_t)l * FFN_H * 1024, FFN_H, 1024, 1024, (u16*)(lw + LW_W2F), 0, smf, bid, nb);
  }
  grid.sync();

  xattn_ffn(p, 0, grid, smem, bid, nb, true);

  {
    u16* Q1 = (u16*)(ws + OFF_S0); u16* K1 = (u16*)(ws + OFF_S1); u16* V1T = (u16*)(ws + OFF_S2); u16* O1 = (u16*)(ws + OFF_S3);
    {
      auto epi = [&](int mw, int nw, f32x16 (&acc)[2][2]) __attribute__((always_inline)) {
        const int wv = tid >> 6;
        const int m0 = mw - (wv >> 1) * 64, n0 = nw - (wv & 1) * 64;
        if (n0 < 2048) {
          u16* dst = (n0 < 1024) ? Q1 : K1;
          const int nn = n0 & 1023;
          stage_tile<0>(acc, smem, [&](int rr, int cc, const u32x4& v) __attribute__((always_inline)) { *(u32x4*)(dst + (size_t)(m0 + rr) * 1024 + nn + cc) = v; });
        } else {
          stage_tile<1>(acc, smem, [&](int rr, int cc, const u32x4& v) __attribute__((always_inline)) {
            const int c = n0 - 2048 + rr, m = m0 + cc;
            *(u32x4*)(V1T + ((size_t)((m >> 12) * 1024 + c)) * 4096 + (m & 4095)) = v;
          });
        }
      };
      gemm_phase22(XB, 1024, XB, 1024, 1024, (const u16*)(ws + OFF_QKV1), 1024, 1024, M_, 3072, smem, epi, bid, nb);
    }
    grid.sync();
    for (int t = bid; t < 1024; t += nb) {
      const int bhh = t >> 4, blk = t & 15, b = bhh >> 4, h = bhh & 15;
      const int d = tid & 63, part = tid >> 6;
      float s = 0.f;
      const u16* src = K1 + ((size_t)b * 4096 + blk * 256 + part * 64) * 1024 + h * 64 + d;
      for (int i = 0; i < 64; ++i) s += bf2f(src[(size_t)i * 1024]);
      __syncthreads();
      smf[part * 64 + d] = s;
      __syncthreads();
      if (tid < 64) KMEAN[(size_t)t * 64 + tid] = (smf[tid] + smf[64 + tid] + smf[128 + tid] + smf[192 + tid]) * (1.f / 256.f);
    }
    grid.sync();
    {
      float* skm = smf;
      int* slist = (int*)(smf + 1024);
      u16* sKV = smem + 4096;
      for (int rpt = 0; rpt < RPT_MOBA; ++rpt)
      for (int t = bid; t < 2048; t += nb) {
        const int rnd = t >> 9, g8 = (t >> 6) & 7;
        const int qt = (rnd == 0) ? 31 - g8 : (rnd == 1) ? g8 : (rnd == 2) ? 23 - g8 : 8 + g8;
        const int bhh = t & 63, b = bhh >> 4, h = bhh & 15, own = qt >> 1;
        __syncthreads();
        for (int i = tid; i < 1024; i += 256) skm[i] = KMEAN[(size_t)bhh * 1024 + i];
        if (tid == 0) slist[65] = 0;
        __syncthreads();
        const int sq = qt * 128 + 32 * wave + lr;
        const size_t tokq = (size_t)b * 4096 + sq;
        bf16x8 qf[4];
#pragma unroll
        for (int ks = 0; ks < 4; ++ks) qf[ks] = ld_frag16(Q1 + tokq * 1024 + h * 64 + 16 * ks + 8 * hh);
        unsigned sel = 0;
        {
          float qv[32];
#pragma unroll
          for (int i = 0; i < 4; ++i) unpack8(*(const u32x4*)(Q1 + tokq * 1024 + h * 64 + 32 * hh + 8 * i), qv + 8 * i);
          float v0 = -INFINITY, v1 = -INFINITY, v2 = -INFINITY; int i0 = -1, i1 = -1, i2 = -1;
          for (int n = 0; n < own; ++n) {
            float part = 0.f;
#pragma unroll
            for (int d = 0; d < 32; ++d) part += qv[d] * skm[n * 64 + 32 * hh + d];
            const float gsc = part + __shfl_xor(part, 32);
            if (gsc > v0) { v2 = v1; i2 = i1; v1 = v0; i1 = i0; v0 = gsc; i0 = n; }
            else if (gsc > v1) { v2 = v1; i2 = i1; v1 = gsc; i1 = n; }
            else if (gsc > v2) { v2 = gsc; i2 = n; }
          }
          if (i0 >= 0) sel |= 1u << i0;
          if (i1 >= 0) sel |= 1u << i1;
          if (i2 >= 0) sel |= 1u << i2;
        }
        unsigned wsel = sel;
#pragma unroll
        for (int o = 1; o < 64; o <<= 1) wsel |= (unsigned)__shfl_xor((int)wsel, o);
        if (lane == 0) atomicOr((unsigned*)&slist[65], wsel);
        __syncthreads();
        if (tid == 0) {
          const unsigned bm = (unsigned)slist[65];
          int n = 0;
          for (int j = 0; j < own; ++j)
            if ((bm >> j) & 1u) for (int kt = 0; kt < 4; ++kt) slist[n++] = (j << 8) | kt;
          const int nown = (qt & 1) * 2 + 2;
          for (int kt = 0; kt < nown; ++kt) slist[n++] = (own << 8) | kt;
          slist[64] = n;
        }
        __syncthreads();
        const int ntile = slist[64];
        f32x16 O[2];
#pragma unroll
        for (int r = 0; r < 16; ++r) { O[0][r] = 0.f; O[1][r] = 0.f; }
        float mrun = -1e30f, lrun = 0.f;
        u32x4 gk0, gk1, gv0, gv1;
        const int lrow = tid >> 2, lcol = (tid & 3) * 16;
#define KV_LOAD(e_) { const int j_ = (e_) >> 8, kt_ = (e_) & 255; const int key0_ = j_ * 256 + kt_ * 64; \
          const u16* kp_ = K1 + ((size_t)b * 4096 + key0_ + lrow) * 1024 + h * 64 + lcol; gk0 = *(const u32x4*)kp_; gk1 = *(const u32x4*)(kp_ + 8); \
          const u16* vp_ = V1T + ((size_t)(bhh * 64 + lrow)) * 4096 + key0_ + lcol; gv0 = *(const u32x4*)vp_; gv1 = *(const u32x4*)(vp_ + 8); }
#define KV_STORE(buf_) { u16* kb_ = sKV + (buf_) * 9216; *(u32x4*)(kb_ + lrow * 72 + lcol) = gk0; *(u32x4*)(kb_ + lrow * 72 + lcol + 8) = gk1; \
          u16* vb_ = kb_ + 4608; *(u32x4*)(vb_ + lrow * 72 + lcol) = gv0; *(u32x4*)(vb_ + lrow * 72 + lcol + 8) = gv1; }
        KV_LOAD(slist[0]);
        KV_STORE(0);
        __syncthreads();
        const float SC = 0.125f * 1.44269504088896f;
        for (int i = 0; i < ntile; ++i) {
          const int e = slist[i]; const int j = e >> 8, kt = e & 255;
          const bool more = (i + 1 < ntile);
          if (more) KV_LOAD(slist[i + 1]);
          const bool isown = (j == own);
          const bool lsel = isown || ((sel >> j) & 1u);
          const bool wact = isown || ((wsel >> j) & 1u);
          if (wact) {
            const u16* kb = sKV + (i & 1) * 9216; const u16* vb = kb + 4608;
#pragma unroll
            for (int sub = 0; sub < 2; ++sub) {
              const int key0 = j * 256 + kt * 64 + 32 * sub;
              if (isown && key0 > qt * 128 + 32 * wave + 31) continue;
              f32x16 Sx;
#pragma unroll
              for (int r = 0; r < 16; ++r) Sx[r] = 0.f;
              __builtin_amdgcn_s_setprio(1);
#pragma unroll
              for (int ks = 0; ks < 4; ++ks) {
                bf16x8 kf = *(const bf16x8*)(kb + (32 * sub + lr) * 72 + 16 * ks + 8 * hh);
                Sx = MFMA(kf, qf[ks], Sx);
              }
              __builtin_amdgcn_s_setprio(0);
              float tmx = -1e30f, ls = 0.f, mnew, alpha;
              if (isown) {
#pragma unroll
                for (int r = 0; r < 16; ++r) {
                  Sx[r] *= SC;
                  if (key0 + crow(r, hh) <= sq) tmx = fmaxf(tmx, Sx[r]);
                }
                tmx = fmaxf(tmx, __shfl_xor(tmx, 32));
                mnew = fmaxf(mrun, tmx);
                alpha = __builtin_amdgcn_exp2f(mrun - mnew);
#pragma unroll
                for (int r = 0; r < 16; ++r) {
                  const float pe = (key0 + crow(r, hh) <= sq) ? __builtin_amdgcn_exp2f(Sx[r] - mnew) : 0.f;
                  Sx[r] = pe; ls += pe;
                }
              } else {
#pragma unroll
                for (int r = 0; r < 16; ++r) tmx = fmaxf(tmx, Sx[r]);
                tmx = lsel ? tmx * SC : -1e30f;
                tmx = fmaxf(tmx, __shfl_xor(tmx, 32));
                mnew = fmaxf(mrun, tmx);
                alpha = __builtin_amdgcn_exp2f(mrun - mnew);
                const float lm = lsel ? 1.f : 0.f;
#pragma unroll
                for (int r = 0; r < 16; ++r) {
                  const float pe = __builtin_amdgcn_exp2f(fminf(__builtin_fmaf(Sx[r], SC, -mnew), 0.f)) * lm;
                  Sx[r] = pe; ls += pe;
                }
              }
              ls += __shfl_xor(ls, 32);
              lrun = lrun * alpha + ls; mrun = mnew;
#pragma unroll
              for (int r = 0; r < 16; ++r) { O[0][r] *= alpha; O[1][r] *= alpha; }
#pragma unroll
              for (int s2 = 0; s2 < 2; ++s2) {
                bf16x8 pf = pack_frag(Sx, s2);
#pragma unroll
                for (int dt = 0; dt < 2; ++dt) {
                  bf16x8 af = ld_frag8x2(vb + (32 * dt + lr) * 72 + 32 * sub + 16 * s2 + 4 * hh);
                  O[dt] = MFMA(af, pf, O[dt]);
                }
              }
            }
          }
          if (more) KV_STORE((i + 1) & 1);
          __syncthreads();
        }
        const float inv = 1.f / lrun;
#pragma unroll
        for (int dt = 0; dt < 2; ++dt)
#pragma unroll
          for (int q4 = 0; q4 < 4; ++q4) {
            uint2 o; o.x = pk2(O[dt][4 * q4] * inv, O[dt][4 * q4 + 1] * inv); o.y = pk2(O[dt][4 * q4 + 2] * inv, O[dt][4 * q4 + 3] * inv);
            *(uint2*)(O1 + tokq * 1024 + h * 64 + 32 * dt + 8 * q4 + 4 * hh) = o;
          }
      }
    }
    grid.sync();
    gemm_phase22(O1, 1024, O1, 1024, 1024, (const u16*)(ws + OFF_OUT1), 1024, 1024, M_, 1024, smem, EpiResid{p.out, p.out}, bid, nb);
    grid.sync();
    ln_phase(p.out, p.in[23] + 1024, p.in[24] + 1024, XB, bid, nb);
    grid.sync();
  }
  xattn_ffn(p, 1, grid, smem, bid, nb, true);
}

extern "C" void kernel_launch(void* const* d_in, const int* in_sizes, int n_in, void* d_out, int out_size, void* d_ws, size_t ws_size,
                              hipStream_t stream) {
  static int grid_blocks = 0;
  if (!grid_blocks) {
    int dev = 0, cus = 0, per_cu = 0;
    hipGetDevice(&dev);
    hipDeviceGetAttribute(&cus, hipDeviceAttributeMultiprocessorCount, dev);
    hipOccupancyMaxActiveBlocksPerMultiprocessor(&per_cu, fwd_megakernel, 256, 0);
    if (per_cu > 2) per_cu = 2;
    if (per_cu < 1) per_cu = 1;
    grid_blocks = cus * per_cu;
  }
  Params p{};
  for (int i = 0; i < 34; ++i) p.in[i] = (const float*)d_in[i];
  p.out = (float*)d_out;
  p.ws = (char*)d_ws;
  hipMemsetAsync((char*)d_ws + OFF_BAR, 0, XCD_BAR_WORDS * sizeof(unsigned), stream);
  void* args[] = {&p};
  hipError_t e = hipLaunchCooperativeKernel((void*)fwd_megakernel, dim3(grid_blocks), dim3(256), args, 0, stream);
  if (e != hipSuccess) fprintf(stderr, "cooperative launch failed: %s (grid %d)\n", hipGetErrorString(e), grid_blocks);
}
```

```cpp
#include <hip/hip_runtime.h>
#include <hip/hip_cooperative_groups.h>
#include <stdint.h>
#include <cstdio>
namespace cg = cooperative_groups;
#define DI __device__ __forceinline__
typedef unsigned short u16;
using bf16x8 = __attribute__((ext_vector_type(8))) short;
using f32x16 = __attribute__((ext_vector_type(16))) float;
using u32x4 = __attribute__((ext_vector_type(4))) unsigned;
#define FRESH_TID() ({ int t_ = (int)threadIdx.x; asm volatile("" : "+v"(t_)); t_; })
#define MFMA(a, b, c) __builtin_amdgcn_mfma_f32_32x32x16_bf16((a), (b), (c), 0, 0, 0)

constexpr int NB_ = 4, S_ = 4096, D_ = 1024, M_ = NB_ * S_;
constexpr int EVEN_IN = 5904, EVEN_IN_PAD = 6016, FFN_H = 2816;
constexpr float ALPHA = 1.41421356237309515f;
constexpr size_t MiB = 1ull << 20;
constexpr size_t OFF_RW = 0, OFF_XBC = 104 * MiB, OFF_Z = 152 * MiB, OFF_WIN = 184 * MiB;
constexpr size_t OFF_WOUT = OFF_WIN + (size_t)EVEN_IN_PAD * 1024 * 2;
constexpr size_t OFF_XB = OFF_WOUT + 4 * MiB;
constexpr size_t OFF_DT = OFF_XB + 32 * MiB;
constexpr size_t OFF_LIN = OFF_DT + 1 * MiB;
constexpr size_t OFF_MEMB = OFF_LIN + 8 * MiB;
constexpr size_t OFF_XAK = OFF_MEMB + 2 * MiB;
constexpr size_t OFF_XAVT = OFF_XAK + 4 * MiB;
constexpr size_t OFF_KMEAN = OFF_XAVT + 4 * MiB;
constexpr size_t OFF_CDEC = OFF_KMEAN + MiB / 4;
constexpr size_t OFF_LORAW = OFF_CDEC + MiB / 4;
constexpr size_t OFF_STATES = OFF_XB, OFF_GG = OFF_XB, OFF_YR = OFF_XBC;
constexpr size_t DO_XT = 0, DO_BM = 32 * MiB, DO_BMT = 40 * MiB, DO_CM = 48 * MiB, DO_WE = 0, DO_AA = 32 * MiB;
constexpr size_t OFF_QKV1 = 0, OFF_OUT1 = 6 * MiB, OFF_LW = 8 * MiB, LW_STRIDE = 49 * MiB / 2;
constexpr size_t LW_WQ = 0, LW_WKV = 2 * MiB, LW_WO = 6 * MiB, LW_W13 = 8 * MiB, LW_W2F = 19 * MiB;
constexpr size_t OFF_S0 = 57 * MiB, OFF_S1 = 89 * MiB, OFF_S2 = 121 * MiB, OFF_S3 = 153 * MiB;

#ifndef RPT_SCAN
#define RPT_SCAN 1
#endif
#ifndef RPT_MOBA
#define RPT_MOBA 1
#endif
#ifndef RPT_FFN
#define RPT_FFN 1
#endif

#define XB_TMO      128
#define XB_XCNT(j)  (256  + 64 * (j))
#define XB_XSUB(j)  (1280 + 64 * (j))
#define XB_XGEN(j)  (2304 + 64 * (j))
#define XB_TOP      3328
#define XB_TOPGEN   3392
#define XCD_BAR_WORDS 3456
#define XB_SPIN_CAP (1u << 18)
#define LAS __attribute__((address_space(3)))
DI unsigned xb_ld(unsigned* p)              { return __hip_atomic_load(p, __ATOMIC_RELAXED, __HIP_MEMORY_SCOPE_AGENT); }
DI unsigned xb_add(unsigned* p, unsigned v) { return __hip_atomic_fetch_add(p, v, __ATOMIC_RELAXED, __HIP_MEMORY_SCOPE_AGENT); }
DI unsigned xb_xcc_id() { return (unsigned)__builtin_amdgcn_s_getreg((3 << 11) | 20) & 0xFu; }
#define XB_SPIN(cond, bar) do { unsigned _sp = 0; while (cond) { __builtin_amdgcn_s_sleep(1); \
    if ((++_sp & 255u) == 0u) { if (xb_ld(&(bar)[XB_TMO])) break; if (_sp > XB_SPIN_CAP) { atomicAdd(&(bar)[XB_TMO], 1u); break; } } } } while (0)
struct XcdBarrier { unsigned* bar; unsigned x; volatile LAS unsigned* st; };
DI XcdBarrier xcd_barrier_post(unsigned* bar, volatile LAS unsigned* st) {
    XcdBarrier b; b.bar = bar; b.x = xb_xcc_id(); b.st = st;
    if (threadIdx.x == 0) (void)xb_add(&bar[XB_XCNT(b.x)], 1u);
    return b;
}
DI void xcd_barrier_complete(unsigned* bar, unsigned x, unsigned& nloc, unsigned& nx) {
    const unsigned G = gridDim.x * gridDim.y * gridDim.z;
    unsigned sum, cnt, mine, sp = 0u;
    for (;;) {
        sum = 0u; cnt = 0u; mine = 0u;
#pragma unroll
        for (unsigned j = 0; j < 16; ++j) { const unsigned c = xb_ld(&bar[XB_XCNT(j)]); sum += c; cnt += (c > 0u) ? 1u : 0u; mine = (j == x) ? c : mine; }
        if (sum == G) break;
        __builtin_amdgcn_s_sleep(1);
        if ((++sp & 255u) == 0u) { if (xb_ld(&bar[XB_TMO])) break; if (sp > XB_SPIN_CAP) { atomicAdd(&bar[XB_TMO], 1u); break; } }
    }
    nloc = mine > 0u ? mine : 1u; nx = cnt > 0u ? cnt : 1u;
}
DI void xcd_barrier(const XcdBarrier& b) {
    asm volatile("s_waitcnt vmcnt(0)" ::: "memory");
    __syncthreads();
    if (threadIdx.x == 0) {
        unsigned* bar = b.bar;
        __builtin_amdgcn_s_waitcnt(0);
        unsigned nloc = b.st[0], nx = b.st[1];
        if (nloc == 0u) { xcd_barrier_complete(bar, b.x, nloc, nx); b.st[0] = nloc; b.st[1] = nx; }
        const unsigned old = xb_add(&bar[XB_XSUB(b.x)], 1u);
        const unsigned gen = old / nloc;
        if (old + 1u == (gen + 1u) * nloc) {
            __builtin_amdgcn_fence(__ATOMIC_RELEASE, "agent");
            asm volatile("s_waitcnt vmcnt(0)" ::: "memory");
            const unsigned og = xb_add(&bar[XB_TOP], 1u);
            const unsigned tg = og / nx;
            if (og + 1u == (tg + 1u) * nx) xb_add(&bar[XB_TOPGEN], 1u);
            else XB_SPIN(xb_ld(&bar[XB_TOPGEN]) == tg, bar);
            __builtin_amdgcn_fence(__ATOMIC_ACQUIRE, "agent");
            xb_add(&bar[XB_XGEN(b.x)], 1u);
            asm volatile("s_waitcnt vmcnt(0)" ::: "memory");
        } else {
            XB_SPIN(xb_ld(&bar[XB_XGEN(b.x)]) == gen, bar);
            __builtin_amdgcn_fence(__ATOMIC_ACQUIRE, "agent");
            asm volatile("s_waitcnt vmcnt(0)" ::: "memory");
        }
    }
    __syncthreads();
}
struct GridBar { XcdBarrier b; DI void sync() const { xcd_barrier(b); } };
constexpr size_t OFF_BAR = 254 * MiB;
struct Params { const float* in[34]; float* out; char* ws; };

typedef __bf16 bf16x2_t __attribute__((ext_vector_type(2)));
typedef float f32x2_t __attribute__((ext_vector_type(2)));
DI u16 f2bf(float x) { return __builtin_bit_cast(u16, (__bf16)x); }
DI float bf2f(u16 b) { return __uint_as_float(((unsigned)b) << 16); }
DI unsigned pk2(float a, float b) { f32x2_t v = {a, b}; return __builtin_bit_cast(unsigned, __builtin_convertvector(v, bf16x2_t)); }
DI float blo(unsigned u) { return __uint_as_float(u << 16); }
DI float bhi(unsigned u) { return __uint_as_float(u & 0xffff0000u); }
template <class V4> DI void unpack8(const V4& v, float* f) {
  f[0] = blo(v.x); f[1] = bhi(v.x); f[2] = blo(v.y); f[3] = bhi(v.y); f[4] = blo(v.z); f[5] = bhi(v.z); f[6] = blo(v.w); f[7] = bhi(v.w);
}
DI uint4 pack8(const float* f) { uint4 v; v.x = pk2(f[0], f[1]); v.y = pk2(f[2], f[3]); v.z = pk2(f[4], f[5]); v.w = pk2(f[6], f[7]); return v; }
DI int crow(int r, int hh) { return (r & 3) + 8 * (r >> 2) + 4 * hh; }
DI float sigmoidf_(float x) { return __builtin_amdgcn_rcpf(1.f + __expf(-x)); }
DI float siluf_(float x) { return x * __builtin_amdgcn_rcpf(1.f + __expf(-x)); }
DI float softplusf_(float x) { return x > 20.f ? x : __logf(1.f + __expf(x)); }
template <int CTRL> DI float dppf(float v) { return __builtin_bit_cast(float, __builtin_amdgcn_update_dpp(0, __builtin_bit_cast(int, v), CTRL, 0xf, 0xf, true)); }
DI float row16_sum(float v) { v += dppf<0xB1>(v); v += dppf<0x4E>(v); v += dppf<0x141>(v); v += dppf<0x140>(v); return v; }
DI bf16x8 pack_frag(const f32x16& x, int s) {
  uint4 p;
  p.x = pk2(x[8 * s + 0], x[8 * s + 1]); p.y = pk2(x[8 * s + 2], x[8 * s + 3]);
  p.z = pk2(x[8 * s + 4], x[8 * s + 5]); p.w = pk2(x[8 * s + 6], x[8 * s + 7]);
  return __builtin_bit_cast(bf16x8, p);
}
DI bf16x8 ld_frag16(const u16* p) { return __builtin_bit_cast(bf16x8, *(const uint4*)p); }
DI bf16x8 ld_frag8x2(const u16* p) { uint2 a = *(const uint2*)p; uint2 b = *(const uint2*)(p + 8); uint4 v; v.x = a.x; v.y = a.y; v.z = b.x; v.w = b.y; return __builtin_bit_cast(bf16x8, v); }

template <int WM, int WN, class Epi>
DI void gemm_tile(const u16* __restrict__ A, int lda, const u16* __restrict__ A2, int lda2, int ksplit,
                  const u16* __restrict__ Bt, int ldb, int K, int m0, int n0, u16* smem, Epi&& epi) {
  constexpr int BM = 64 * WM, BN = 64 * WN, LD = 72;
  constexpr int NA = BM * 8 / 256, NBL = BN * 8 / 256;
  u16* sA = smem; u16* sB = smem + BM * LD;
  const int tid = threadIdx.x, lane = tid & 63, wave = tid >> 6, wm = wave >> 1, wn = wave & 1;
  u32x4 ra[NA], rb[NBL];
  f32x16 acc[WM][WN];
#pragma unroll
  for (int i = 0; i < WM; ++i)
#pragma unroll
    for (int j = 0; j < WN; ++j)
#pragma unroll
      for (int r = 0; r < 16; ++r) acc[i][j][r] = 0.f;
#define GLOAD(k0_) { const u16* Ap; int ld, kk; \
    if ((k0_) < ksplit) { Ap = A; ld = lda; kk = (k0_); } else { Ap = A2; ld = lda2; kk = (k0_) - ksplit; } \
    _Pragma("unroll") for (int i = 0; i < NA; ++i) { int c = tid + 256 * i; int row = c >> 3, col = (c & 7) * 8; ra[i] = *(const u32x4*)(Ap + (size_t)(m0 + row) * ld + kk + col); } \
    _Pragma("unroll") for (int i = 0; i < NBL; ++i) { int c = tid + 256 * i; int row = c >> 3, col = (c & 7) * 8; rb[i] = *(const u32x4*)(Bt + (size_t)(n0 + row) * ldb + (k0_) + col); } }
#define SSTORE() { \
    _Pragma("unroll") for (int i = 0; i < NA; ++i) { int c = tid + 256 * i; int row = c >> 3, col = (c & 7) * 8; *(u32x4*)(sA + row * LD + col) = ra[i]; } \
    _Pragma("unroll") for (int i = 0; i < NBL; ++i) { int c = tid + 256 * i; int row = c >> 3, col = (c & 7) * 8; *(u32x4*)(sB + row * LD + col) = rb[i]; } }
  constexpr bool DB = (2 * (BM + BN) * LD * 2 <= 72 * 1024);
  constexpr int STAGE = (BM + BN) * LD;
  const int lr = lane & 31, hh = lane >> 5;
  GLOAD(0);
  __syncthreads();
  SSTORE();
  __syncthreads();
  int buf = 0;
  for (int k0 = 0; k0 < K; k0 += 64) {
    const bool more = (k0 + 64 < K);
    if (more) GLOAD(k0 + 64);
    if constexpr (DB) __builtin_amdgcn_sched_barrier(0);
    __builtin_amdgcn_s_setprio(1);
    {
      const u16* cA = smem + (DB ? buf * STAGE : 0);
      const u16* cB = cA + BM * LD;
      if constexpr (DB) {
        bf16x8 af[2][WM], bfr[2][WN];
#pragma unroll
        for (int i = 0; i < WM; ++i) af[0][i] = *(const bf16x8*)(cA + (wm * 32 * WM + i * 32 + lr) * LD + hh * 8);
#pragma unroll
        for (int j = 0; j < WN; ++j) bfr[0][j] = *(const bf16x8*)(cB + (wn * 32 * WN + j * 32 + lr) * LD + hh * 8);
#pragma unroll
        for (int ks = 0; ks < 4; ++ks) {
          if (ks + 1 < 4) {
#pragma unroll
            for (int i = 0; i < WM; ++i) af[(ks + 1) & 1][i] = *(const bf16x8*)(cA + (wm * 32 * WM + i * 32 + lr) * LD + (ks + 1) * 16 + hh * 8);
#pragma unroll
            for (int j = 0; j < WN; ++j) bfr[(ks + 1) & 1][j] = *(const bf16x8*)(cB + (wn * 32 * WN + j * 32 + lr) * LD + (ks + 1) * 16 + hh * 8);
          }
#pragma unroll
          for (int i = 0; i < WM; ++i)
#pragma unroll
            for (int j = 0; j < WN; ++j) acc[i][j] = MFMA(af[ks & 1][i], bfr[ks & 1][j], acc[i][j]);
        }
      } else {
#pragma unroll
        for (int ks = 0; ks < 4; ++ks) {
          bf16x8 af[WM], bfr[WN];
#pragma unroll
          for (int i = 0; i < WM; ++i) af[i] = *(const bf16x8*)(cA + (wm * 32 * WM + i * 32 + lr) * LD + ks * 16 + hh * 8);
#pragma unroll
          for (int j = 0; j < WN; ++j) bfr[j] = *(const bf16x8*)(cB + (wn * 32 * WN + j * 32 + lr) * LD + ks * 16 + hh * 8);
#pragma unroll
          for (int i = 0; i < WM; ++i)
#pragma unroll
            for (int j = 0; j < WN; ++j) acc[i][j] = MFMA(af[i], bfr[j], acc[i][j]);
        }
      }
    }
    __builtin_amdgcn_s_setprio(0);
    if constexpr (DB) __builtin_amdgcn_sched_barrier(0);
    if (DB) {
      if (more) {
        u16* sA = smem + (buf ^ 1) * STAGE; u16* sB = sA + BM * LD;
        SSTORE();
      }
      __syncthreads();
      buf ^= 1;
    } else {
      __syncthreads();
      if (more) SSTORE();
      __syncthreads();
    }
  }
  epi(m0 + wm * 32 * WM, n0 + wn * 32 * WN, acc);
}

DI void conv_weight(const float* __restrict__ W, int K, int N, int Npad, u16* __restrict__ Wt, int mode, float* sT, int bid, int nb) {
  const int tid = threadIdx.x;
  const int ktn = K / 64, ntn = Npad / 128;
  for (int t = bid; t < ktn * ntn; t += nb) {
    const int kt = t / ntn, nt = t % ntn;
    float4 wv[8];
#pragma unroll
    for (int i = 0; i < 8; ++i) {
      int e = tid + 256 * i; int kk = e >> 5, nn = (e & 31) * 4; int n = nt * 128 + nn;
      wv[i] = (n < N) ? *(const float4*)(W + (size_t)(kt * 64 + kk) * N + n) : make_float4(0.f, 0.f, 0.f, 0.f);
    }
    __syncthreads();
#pragma unroll
    for (int i = 0; i < 8; ++i) {
      int e = tid + 256 * i; int kk = e >> 5, nn = (e & 31) * 4;
      sT[kk * 129 + nn] = wv[i].x; sT[kk * 129 + nn + 1] = wv[i].y; sT[kk * 129 + nn + 2] = wv[i].z; sT[kk * 129 + nn + 3] = wv[i].w;
    }
    __syncthreads();
#pragma unroll
    for (int i = 0; i < 4; ++i) {
      int c = tid + 256 * i; int nn = c >> 3, k8 = (c & 7) * 8;
      float f[8];
#pragma unroll
      for (int q = 0; q < 8; ++q) f[q] = sT[(k8 + q) * 129 + nn];
      int n = nt * 128 + nn, row = n;
      if (mode == 1) { int j = (n < FFN_H) ? n : n - FFN_H; row = (j >> 5) * 64 + (j & 31) + ((n < FFN_H) ? 0 : 32); }
      *(uint4*)(Wt + (size_t)row * K + kt * 64 + k8) = pack8(f);
    }
  }
}

DI void conv_act(const float* __restrict__ src, u16* __restrict__ dst, size_t n, int bid, int nb) {
  const size_t stride = (size_t)nb * 256 * 8;
  size_t i = ((size_t)bid * 256 + threadIdx.x) * 8;
  for (; i + 3 * stride < n; i += 4 * stride) {
    float4 a[4], b[4];
#pragma unroll
    for (int u = 0; u < 4; ++u) { a[u] = *(const float4*)(src + i + u * stride); b[u] = *(const float4*)(src + i + u * stride + 4); }
#pragma unroll
    for (int u = 0; u < 4; ++u) {
      float f[8] = {a[u].x, a[u].y, a[u].z, a[u].w, b[u].x, b[u].y, b[u].z, b[u].w};
      *(uint4*)(dst + i + u * stride) = pack8(f);
    }
  }
  for (; i < n; i += stride) {
    float4 a = *(const float4*)(src + i), b = *(const float4*)(src + i + 4);
    float f[8] = {a.x, a.y, a.z, a.w, b.x, b.y, b.z, b.w};
    *(uint4*)(dst + i) = pack8(f);
  }
}

DI void ln_phase(float* __restrict__ X, const float* __restrict__ g, const float* __restrict__ bta, u16* __restrict__ XB, int bid, int nb) {
  const int lane = threadIdx.x & 63, wave = threadIdx.x >> 6;
  for (int row = bid * 4 + wave; row < M_; row += nb * 4) {
    float* xr = X + (size_t)row * 1024;
    float4 v[4];
    float s = 0.f;
#pragma unroll
    for (int i = 0; i < 4; ++i) { v[i] = *(const float4*)(xr + 4 * lane + 256 * i); s += v[i].x + v[i].y + v[i].z + v[i].w; }
#pragma unroll
    for (int o = 32; o > 0; o >>= 1) s += __shfl_xor(s, o);
    const float mu = s * (1.f / 1024.f);
    float q = 0.f;
#pragma unroll
    for (int i = 0; i < 4; ++i) { float a = v[i].x - mu, b = v[i].y - mu, c = v[i].z - mu, d = v[i].w - mu; q += a * a + b * b + c * c + d * d; }
#pragma unroll
    for (int o = 32; o > 0; o >>= 1) q += __shfl_xor(q, o);
    const float rs = rsqrtf(q * (1.f / 1024.f) + 1e-5f);
#pragma unroll
    for (int i = 0; i < 4; ++i) {
      const int c = 4 * lane + 256 * i;
      float4 gg = *(const float4*)(g + c), bb = *(const float4*)(bta + c), o;
      o.x = (v[i].x - mu) * rs * gg.x + bb.x; o.y = (v[i].y - mu) * rs * gg.y + bb.y;
      o.z = (v[i].z - mu) * rs * gg.z + bb.z; o.w = (v[i].w - mu) * rs * gg.w + bb.w;
      *(float4*)(xr + c) = o;
      uint2 pb; pb.x = pk2(o.x, o.y); pb.y = pk2(o.z, o.w);
      *(uint2*)(XB + (size_t)row * 1024 + c) = pb;
    }
  }
}

DI void block_cumsum128(float* s) {
  const int tid = threadIdx.x, lane = tid & 63;
  __syncthreads();
  float v = (tid < 128) ? s[tid] : 0.f;
#pragma unroll
  for (int off = 1; off < 64; off <<= 1) { const float u = __shfl_up(v, off); if (lane >= off) v += u; }
  if (tid < 64) s[tid] = v;
  __syncthreads();
  if (tid >= 64 && tid < 128) s[tid] = v + s[63];
  __syncthreads();
}

struct EpiResid {
  const float* R; float* X;
  template <class ACC> DI void operator()(int mw, int nw, ACC& acc) const {
    const int lr = threadIdx.x & 31, hh = (threadIdx.x & 63) >> 5;
#pragma unroll
    for (int i = 0; i < 2; ++i)
#pragma unroll
      for (int j = 0; j < 2; ++j)
#pragma unroll
        for (int r = 0; r < 16; ++r) {
          size_t idx = (size_t)(mw + 32 * i + crow(r, hh)) * 1024 + nw + 32 * j + lr;
          X[idx] = ALPHA * R[idx] + acc[i][j][r];
        }
  }
};
template <int TRANS, class F>
DI void stage_tile(f32x16 (&acc)[2][2], u16* sT, F&& f) {
  const int tid = threadIdx.x, lane = tid & 63, wave = tid >> 6, wm = wave >> 1, wn = wave & 1, lr = lane & 31, hh = lane >> 5;
#pragma unroll
  for (int i = 0; i < 2; ++i)
#pragma unroll
    for (int j = 0; j < 2; ++j)
#pragma unroll
      for (int r = 0; r < 16; ++r) {
        const int row = wm * 64 + 32 * i + crow(r, hh), col = wn * 64 + 32 * j + lr;
        sT[TRANS ? col * 136 + row : row * 136 + col] = f2bf(acc[i][j][r]);
      }
  __syncthreads();
#pragma unroll
  for (int q = 0; q < 8; ++q) {
    const int c = tid + 256 * q; const int rr = c >> 4, cc = (c & 15) * 8;
    f(rr, cc, *(const u32x4*)(sT + rr * 136 + cc));
  }
}
struct EpiBf16 {
  u16* C; int ldc; u16* sT;
  template <class ACC> DI void operator()(int mw, int nw, ACC& acc) const {
    const int wave = threadIdx.x >> 6;
    const int m0 = mw - (wave >> 1) * 64, n0 = nw - (wave & 1) * 64;
    u16* Cp = C; const int ld = ldc;
    stage_tile<0>(acc, sT, [&](int rr, int cc, const u32x4& v) __attribute__((always_inline)) { *(u32x4*)(Cp + (size_t)(m0 + rr) * ld + n0 + cc) = v; });
  }
};

template <class Epi>
DI void gemm_phase22(const u16* A, int lda, const u16* A2, int lda2, int ksplit, const u16* Bt, int ldb, int K, int Mrows, int Ncols,
                     u16* smem, Epi&& epi, int bid, int nb) {
  const int ntn = Ncols / 128, ntm = Mrows / 128;
  if ((ntm & 63) == 0 && (nb & 7) == 0) {
    const int xcd = bid & 7, local = bid >> 3, nlocal = nb >> 3, mper = ntm >> 3;
    for (int idx = local; idx < mper * ntn; idx += nlocal) {
      const int sm = idx / (8 * ntn), rem = idx - sm * 8 * ntn, tn = rem >> 3, tmi = rem & 7;
      gemm_tile<2, 2>(A, lda, A2, lda2, ksplit, Bt, ldb, K, (xcd * mper + sm * 8 + tmi) * 128, tn * 128, smem, epi);
    }
  } else {
    for (int t = bid; t < ntm * ntn; t += nb) gemm_tile<2, 2>(A, lda, A2, lda2, ksplit, Bt, ldb, K, (t / ntn) * 128, (t % ntn) * 128, smem, epi);
  }
}

DI void xattn_ffn(const Params& p, int layer, const GridBar& grid, u16* smem, int bid, int nb, bool conv_mem_kv) {
  char* ws = p.ws;
  float* X = p.out;
  u16* XB = (u16*)(ws + OFF_XB);
  const char* lw = ws + OFF_LW + LW_STRIDE * layer;
  const u16* WQ = (const u16*)(lw + LW_WQ); const u16* WKV = (const u16*)(lw + LW_WKV); const u16* WO = (const u16*)(lw + LW_WO);
  const u16* W13 = (const u16*)(lw + LW_W13); const u16* W2F = (const u16*)(lw + LW_W2F);
  u16* Q = (u16*)(ws + OFF_S0); u16* Pm = (u16*)(ws + OFF_S1); u16* O = (u16*)(ws + OFF_S2); u16* H = (u16*)(ws + OFF_S0);
  u16* XAK = (u16*)(ws + OFF_XAK) + (size_t)layer * 1024 * 1024;
  u16* XAVT = (u16*)(ws + OFF_XAVT) + (size_t)layer * 1024 * 1024;
  const u16* MEMB = (const u16*)(ws + OFF_MEMB);
  const int tid = threadIdx.x, lane = tid & 63, lr = lane & 31, hh = lane >> 5;
  gemm_phase22(XB, 1024, XB, 1024, 1024, WQ, 1024, 1024, M_, 1024, smem, EpiBf16{Q, 1024, smem}, bid, nb);
  {
    auto epi = [&](int mw, int nw, f32x16 (&acc)[2][2]) __attribute__((always_inline)) {
      const int wv = tid >> 6;
      const int m0 = mw - (wv >> 1) * 64, n0 = nw - (wv & 1) * 64;
      if (n0 < 1024) {
        stage_tile<0>(acc, smem, [&](int rr, int cc, const u32x4& v) __attribute__((always_inline)) { *(u32x4*)(XAK + (size_t)(m0 + rr) * 1024 + n0 + cc) = v; });
      } else {
        stage_tile<1>(acc, smem, [&](int rr, int cc, const u32x4& v) __attribute__((always_inline)) {
          const int c = n0 - 1024 + rr, m = m0 + cc;
          *(u32x4*)(XAVT + ((size_t)((m >> 8) * 1024 + c)) * 256 + (m & 255)) = v;
        });
      }
    };
    gemm_phase22(MEMB, 1024, MEMB, 1024, 1024, WKV, 1024, 1024, 1024, 2048, smem, epi, (bid + nb / 2) % nb, nb);
  }
  grid.sync();
  {
    float* sred = (float*)(smem + 35840);
    u16* sP = smem;
    u16* sV = smem + 17408;
    for (int t = bid; t < 16 * 64; t += nb) {
      const int tid = FRESH_TID(), lane = tid & 63, lr = lane & 31, hh = lane >> 5, wave = tid >> 6, wm = wave >> 1, wn = wave & 1;
      const int bh = t >> 6, tm = t & 63, b = bh >> 2, h = bh & 3;
      const u16* Ab = Q + (size_t)b * 4096 * 1024 + h * 256;
      const u16* Bb = XAK + (size_t)b * 256 * 1024 + h * 256;
      const u16* Vb = XAVT + (size_t)bh * 256 * 256;
      u16* Ob = O + (size_t)b * 4096 * 1024 + h * 256;
      auto epi = [&](int mw, int nw, f32x16 (&acc)[1][4]) __attribute__((always_inline)) {
        float mx[16];
#pragma unroll
        for (int r = 0; r < 16; ++r) {
          float v = -1e30f;
#pragma unroll
          for (int j = 0; j < 4; ++j) { acc[0][j][r] *= 0.0625f; v = fmaxf(v, acc[0][j][r]); }
#pragma unroll
          for (int o = 16; o > 0; o >>= 1) v = fmaxf(v, __shfl_xor(v, o));
          mx[r] = v;
        }
        const int rbase = mw - tm * 64;
        if (lr == 0) {
#pragma unroll
          for (int r = 0; r < 16; ++r) sred[wn * 64 + rbase + crow(r, hh)] = mx[r];
        }
        __syncthreads();
        float sm[16];
#pragma unroll
        for (int r = 0; r < 16; ++r) {
          const int row = rbase + crow(r, hh);
          const float m2 = fmaxf(sred[row], sred[64 + row]);
          float s = 0.f;
#pragma unroll
          for (int j = 0; j < 4; ++j) { float e = __expf(acc[0][j][r] - m2); acc[0][j][r] = e; s += e; }
#pragma unroll
          for (int o = 16; o > 0; o >>= 1) s += __shfl_xor(s, o);
          sm[r] = s;
        }
        if (lr == 0) {
#pragma unroll
          for (int r = 0; r < 16; ++r) sred[128 + wn * 64 + rbase + crow(r, hh)] = sm[r];
        }
        __syncthreads();
#pragma unroll
        for (int r = 0; r < 16; ++r) {
          const int row = rbase + crow(r, hh);
          const float inv = __builtin_amdgcn_rcpf(sred[128 + row] + sred[192 + row]);
#pragma unroll
          for (int j = 0; j < 4; ++j) sP[row * 264 + nw + 32 * j + lr] = f2bf(acc[0][j][r] * inv);
        }
        __builtin_amdgcn_sched_barrier(0);
        u32x4 vr[8];
#pragma unroll
        for (int i = 0; i < 8; ++i) { const int c = tid + 256 * i; vr[i] = *(const u32x4*)(Vb + (size_t)(c >> 3) * 256 + (c & 7) * 8); }
        f32x16 o2[4];
#pragma unroll
        for (int j = 0; j < 4; ++j)
#pragma unroll
          for (int r = 0; r < 16; ++r) o2[j][r] = 0.f;
#pragma unroll 1
        for (int kt = 0; kt < 4; ++kt) {
          __syncthreads();
#pragma unroll
          for (int i = 0; i < 8; ++i) { const int c = tid + 256 * i; *(u32x4*)(sV + (c >> 3) * 72 + (c & 7) * 8) = vr[i]; }
          if (kt + 1 < 4) {
#pragma unroll
            for (int i = 0; i < 8; ++i) { const int c = tid + 256 * i; vr[i] = *(const u32x4*)(Vb + (size_t)(c >> 3) * 256 + (kt + 1) * 64 + (c & 7) * 8); }
          }
          __syncthreads();
#pragma unroll
          for (int ks = 0; ks < 4; ++ks) {
            const bf16x8 af = *(const bf16x8*)(sP + (wm * 32 + lr) * 264 + kt * 64 + ks * 16 + hh * 8);
#pragma unroll
            for (int j = 0; j < 4; ++j) {
              const bf16x8 bfr = *(const bf16x8*)(sV + (wn * 128 + 32 * j + lr) * 72 + ks * 16 + hh * 8);
              o2[j] = MFMA(af, bfr, o2[j]);
            }
          }
        }
        __syncthreads();
#pragma unroll
        for (int j = 0; j < 4; ++j)
#pragma unroll
          for (int r = 0; r < 16; ++r) sP[(rbase + crow(r, hh)) * 264 + wn * 128 + 32 * j + lr] = f2bf(o2[j][r]);
        __syncthreads();
#pragma unroll
        for (int q = 0; q < 8; ++q) {
          const int c = tid + 256 * q; const int rr = c >> 5, cc = (c & 31) * 8;
          *(u32x4*)(Ob + (size_t)(tm * 64 + rr) * 1024 + cc) = *(const u32x4*)(sP + rr * 264 + cc);
        }
      };
      gemm_tile<1, 4>(Ab, 1024, Ab, 1024, 256, Bb, 1024, 256, tm * 64, 0, smem, epi);
    }
  }
  grid.sync();
  gemm_phase22(O, 1024, O, 1024, 1024, WO, 1024, 1024, M_, 1024, smem, EpiResid{X, X}, bid, nb);
  grid.sync();
  ln_phase(X, p.in[28] + layer * 1024, p.in[29] + layer * 1024, XB, bid, nb);
  grid.sync();
  {
    auto epi = [&](int mw, int nw, f32x16 (&acc)[2][2]) __attribute__((always_inline)) {
      const int wv = tid >> 6, wm_ = wv >> 1, wn_ = wv & 1;
      const int m0 = mw - wm_ * 64, n0 = nw - wn_ * 64;
      u16* sT = smem;
#pragma unroll
      for (int i = 0; i < 2; ++i)
#pragma unroll
        for (int r = 0; r < 16; ++r) {
          const float g = acc[i][0][r], u = acc[i][1][r];
          sT[(wm_ * 64 + 32 * i + crow(r, hh)) * 72 + wn_ * 32 + lr] = f2bf(siluf_(g) * u);
        }
      __syncthreads();
#pragma unroll
      for (int q = 0; q < 4; ++q) {
        const int c = tid + 256 * q; const int rr = c >> 3, cc = (c & 7) * 8;
        *(u32x4*)(H + (size_t)(m0 + rr) * FFN_H + (n0 >> 1) + cc) = *(const u32x4*)(sT + rr * 72 + cc);
      }
    };
    for (int rpt = 0; rpt < RPT_FFN; ++rpt)
    gemm_phase22(XB, 1024, XB, 1024, 1024, W13, 1024, 1024, M_, 2 * FFN_H, smem, epi, bid, nb);
  }
  grid.sync();
  gemm_phase22(H, FFN_H, H, FFN_H, FFN_H, W2F, FFN_H, FFN_H, M_, 1024, smem, EpiResid{X, X}, bid, nb);
  grid.sync();
  ln_phase(X, p.in[32] + layer * 1024, p.in[33] + layer * 1024, XB, bid, nb);
  if (layer == 0) grid.sync();
}

__global__ void __launch_bounds__(256, 2) fwd_megakernel(Params p) {
  __shared__ __attribute__((aligned(16))) char smem_raw[72 * 1024];
  __shared__ uint4 xb_words;
  if (p.ws == nullptr) cg::this_grid().sync();
  if (threadIdx.x == 0) xb_words = make_uint4(0u, 0u, 0u, 0u);
  __syncthreads();
  GridBar grid;
  grid.b = xcd_barrier_post((unsigned*)(p.ws + OFF_BAR), (volatile LAS unsigned*)&xb_words);
  u16* smem = (u16*)smem_raw;
  float* smf = (float*)smem_raw;
  const int bid = blockIdx.x, nb = gridDim.x, tid = threadIdx.x, lane = tid & 63, wave = tid >> 6, lr = lane & 31, hh = lane >> 5;
  char* ws = p.ws;
  char* dout = (char*)p.out;
  u16* RW = (u16*)(ws + OFF_RW); u16* XBC = (u16*)(ws + OFF_XBC); u16* Z = (u16*)(ws + OFF_Z);
  u16* WIN = (u16*)(ws + OFF_WIN); u16* WOUT = (u16*)(ws + OFF_WOUT); u16* XB = (u16*)(ws + OFF_XB);
  float* DT = (float*)(ws + OFF_DT); u16* LIN = (u16*)(ws + OFF_LIN); u16* MEMB = (u16*)(ws + OFF_MEMB);
  float* KMEAN = (float*)(ws + OFF_KMEAN); float* CDEC = (float*)(ws + OFF_CDEC);
  u16* W2T = (u16*)(ws + OFF_LORAW); u16* A2T = W2T + 1024 * 64; u16* G2T = A2T + 1024 * 64;
  u16* XT = (u16*)(dout + DO_XT); u16* BM = (u16*)(dout + DO_BM); u16* BMT = (u16*)(dout + DO_BMT); u16* CM = (u16*)(dout + DO_CM);
  u16* WE = (u16*)(dout + DO_WE); u16* AA = (u16*)(dout + DO_AA);
  u16* STATES = (u16*)(ws + OFF_STATES); u16* GG = (u16*)(ws + OFF_GG); u16* YR = (u16*)(ws + OFF_YR);

  conv_weight(p.in[2], 1024, EVEN_IN, EVEN_IN_PAD, WIN, 0, smf, bid, nb);
  conv_weight(p.in[20], 2048, 1024, 1024, WOUT, 0, smf, bid, nb);
  conv_weight(p.in[11], 64, 1024, 1024, W2T, 0, smf, bid, nb);
  conv_weight(p.in[13], 64, 1024, 1024, A2T, 0, smf, bid, nb);
  conv_weight(p.in[14], 128, 1024, 1024, G2T, 0, smf, bid, nb);
  conv_act(p.in[0], XB, (size_t)M_ * 1024, bid, nb);
  conv_act(p.in[1], MEMB, (size_t)1024 * 1024, bid, nb);
  grid.sync();

  {
    const float* dtb = p.in[5];
    auto epi = [&](int mw, int nw, f32x16 (&acc)[2][2]) __attribute__((always_inline)) {
      const int wv = tid >> 6;
      const int m0 = mw - (wv >> 1) * 64, n0 = nw - (wv & 1) * 64;
      if (nw == 2560 && lr < 16) {
#pragma unroll
        for (int i = 0; i < 2; ++i)
#pragma unroll
          for (int r = 0; r < 16; ++r) DT[(size_t)(mw + 32 * i + crow(r, hh)) * 16 + lr] = softplusf_(acc[i][0][r] + dtb[lr]);
      }
      stage_tile<0>(acc, smem, [&](int rr, int cc, const u32x4& v) __attribute__((always_inline)) {
        const int n = n0 + cc; const size_t m = m0 + rr;
        if (n < 1024) *(u32x4*)(Z + m * 1024 + n) = v;
        else if (n < 2560) *(u32x4*)(XBC + m * 1536 + (n - 1024)) = v;
        else if (n < 2576) { }
        else if (n < EVEN_IN) *(u32x4*)(RW + m * 3328 + (n - 2576)) = v;
      });
    };
    gemm_phase22(XB, 1024, XB, 1024, 1024, WIN, 1024, 1024, M_, EVEN_IN_PAD, smem, epi, bid, nb);
  }
  grid.sync();

  {
    const float* cw = p.in[3]; const float* cb = p.in[4];
    u16* sT = smem;
    for (int t = bid; t < 256 * 24; t += nb) {
      const int tt = t / 24, ct = t % 24;
      const int tok = tid >> 2, cq = tid & 3;
      const int gt = tt * 64 + tok, s = gt & 4095;
      const int c0 = ct * 64 + cq * 16;
      float accv[16];
#pragma unroll
      for (int q = 0; q < 16; ++q) accv[q] = cb[c0 + q];
      u32x4 xv[4][2];
#pragma unroll
      for (int k = 0; k < 4; ++k) {
        const int kk = (s - 3 + k >= 0) ? k : 3;
        const u16* src = XBC + (size_t)(gt - 3 + kk) * 1536 + c0;
        xv[k][0] = *(const u32x4*)src; xv[k][1] = *(const u32x4*)(src + 8);
      }
#pragma unroll
      for (int k = 0; k < 4; ++k) {
        float f[16];
        unpack8(xv[k][0], f); unpack8(xv[k][1], f + 8);
        const float msk = (s - 3 + k >= 0) ? 1.f : 0.f;
#pragma unroll
        for (int q = 0; q < 16; ++q) accv[q] += cw[k * 1536 + c0 + q] * (f[q] * msk);
      }
#pragma unroll
      for (int q = 0; q < 16; ++q) accv[q] = siluf_(accv[q]);
      const bool transposed = (ct < 20);
      if (ct >= 16) {
        u16* dst = (ct < 20 ? BM : CM) + (size_t)gt * 256 + ((ct - 16) & 3) * 64 + cq * 16;
        *(uint4*)dst = pack8(accv); *(uint4*)(dst + 8) = pack8(accv + 8);
      }
      if (transposed) {
        __syncthreads();
#pragma unroll
        for (int q = 0; q < 16; ++q) sT[(cq * 16 + q) * 72 + tok] = f2bf(accv[q]);
        __syncthreads();
        const int ch = tid >> 2, tq = tid & 3;
        const int b = tt >> 6, s0 = (tt & 63) * 64;
        u16* dst;
        if (ct < 16) dst = XT + ((size_t)((b * 16 + ct) * 64 + ch)) * 4096 + s0 + tq * 16;
        else dst = BMT + ((size_t)(b * 256 + (ct - 16) * 64 + ch)) * 4096 + s0 + tq * 16;
        *(uint4*)dst = *(const uint4*)(sT + ch * 72 + tq * 16);
        *(uint4*)(dst + 8) = *(const uint4*)(sT + ch * 72 + tq * 16 + 8);
      }
    }
    const float* mu = p.in[9];
    for (int i = bid * 256 + tid; i < M_ * 32; i += nb * 256) {
      const int gt = i >> 5, c8 = (i & 31) * 8, s = gt & 4095;
      const u16* cur = RW + (size_t)gt * 3328 + 3072 + c8;
      float fc[8], fp[8];
      unpack8(*(const uint4*)cur, fc);
      if (s > 0) unpack8(*(const uint4*)(cur - 3328), fp);
      else {
#pragma unroll
        for (int q = 0; q < 8; ++q) fp[q] = 0.f;
      }
      float o[8];
#pragma unroll
      for (int q = 0; q < 8; ++q) {
        float v = fc[q] + (fp[q] - fc[q]) * mu[3072 + c8 + q];
        o[q] = (c8 < 64) ? tanhf(v) : ((c8 < 128) ? v : sigmoidf_(v));
      }
      *(uint4*)(LIN + (size_t)gt * 256 + c8) = pack8(o);
    }
  }
  grid.sync();

  {
    u16* sBt = smem;
    u16* sX = smem + 128 * 136;
    float* sac = (float*)(smem + 192 * 136);
    float* ssc = sac + 128;
    const float* alog = p.in[6];
    const int lrow = tid >> 4, lcol = (tid & 15) * 8;
    for (int t = bid; t < 512; t += nb) {
      const int b = t >> 7, c = (t >> 2) & 31, g = (t >> 1) & 1, half = t & 1;
      const int tok0 = b * 4096 + c * 128;
      u32x4 bt[8];
#pragma unroll
      for (int i = 0; i < 8; ++i) bt[i] = *(const u32x4*)(BMT + ((size_t)((b * 2 + g) * 128 + lrow + 16 * i)) * 4096 + c * 128 + lcol);
      __syncthreads();
#pragma unroll
      for (int i = 0; i < 8; ++i) *(u32x4*)(sBt + (lrow + 16 * i) * 136 + lcol) = bt[i];
      for (int hq = 0; hq < 4; ++hq) {
        const int h = g * 8 + half * 4 + hq;
        const int ti = (b * 32 + c) * 16 + h;
        const float aneg = -__expf(alog[h]);
        u32x4 xv[4];
#pragma unroll
        for (int i = 0; i < 4; ++i) xv[i] = *(const u32x4*)(XT + ((size_t)((b * 16 + h) * 64 + lrow + 16 * i)) * 4096 + c * 128 + lcol);
        float dtv = 0.f;
        if (tid < 128) dtv = DT[(size_t)(tok0 + tid) * 16 + h];
        __syncthreads();
        if (tid < 128) sac[tid] = dtv * aneg;
        block_cumsum128(sac);
        const float alast = sac[127];
        if (tid < 128) ssc[tid] = dtv * __expf(alast - sac[tid]);
        if (tid == 0) CDEC[ti] = __expf(alast);
        __syncthreads();
        {
          const float4 s0 = *(const float4*)(ssc + lcol), s1 = *(const float4*)(ssc + lcol + 4);
#pragma unroll
          for (int i = 0; i < 4; ++i) {
            float f[8];
            unpack8(xv[i], f);
            f[0] *= s0.x; f[1] *= s0.y; f[2] *= s0.z; f[3] *= s0.w; f[4] *= s1.x; f[5] *= s1.y; f[6] *= s1.z; f[7] *= s1.w;
            *(uint4*)(sX + (lrow + 16 * i) * 136 + lcol) = pack8(f);
          }
        }
        __syncthreads();
        f32x16 acc[2];
#pragma unroll
        for (int r = 0; r < 16; ++r) { acc[0][r] = 0.f; acc[1][r] = 0.f; }
#pragma unroll
        for (int ks = 0; ks < 8; ++ks) {
          const bf16x8 bf = *(const bf16x8*)(sBt + (32 * wave + lr) * 136 + 16 * ks + 8 * hh);
#pragma unroll
          for (int pt = 0; pt < 2; ++pt) {
            const bf16x8 af = *(const bf16x8*)(sX + (32 * pt + lr) * 136 + 16 * ks + 8 * hh);
            acc[pt] = MFMA(af, bf, acc[pt]);
          }
        }
        u16* dst = STATES + (size_t)ti * 8192;
#pragma unroll
        for (int pt = 0; pt < 2; ++pt)
#pragma unroll
          for (int r = 0; r < 16; ++r) dst[(32 * pt + crow(r, hh)) * 128 + 32 * wave + lr] = f2bf(acc[pt][r]);
      }
    }
  }
  grid.sync();

  for (int gt = bid * 256 + tid; gt < 65536; gt += nb * 256) {
    const int bhh = gt >> 10, e = (gt & 1023) * 8, b = bhh >> 4, h = bhh & 15;
    float carry[8];
#pragma unroll
    for (int q = 0; q < 8; ++q) carry[q] = 0.f;
    for (int cb8 = 0; cb8 < 32; cb8 += 8) {
      u32x4 sv8[8]; float dec8[8];
#pragma unroll
      for (int i = 0; i < 8; ++i) {
        const int ti = (b * 32 + cb8 + i) * 16 + h;
        sv8[i] = *(const u32x4*)(STATES + (size_t)ti * 8192 + e);
        dec8[i] = CDEC[ti];
      }
#pragma unroll
      for (int i = 0; i < 8; ++i) {
        const int ti = (b * 32 + cb8 + i) * 16 + h;
        float st[8];
        unpack8(sv8[i], st);
        *(uint4*)(STATES + (size_t)ti * 8192 + e) = pack8(carry);
#pragma unroll
        for (int q = 0; q < 8; ++q) carry[q] = carry[q] * dec8[i] + st[q];
      }
    }
  }
  grid.sync();

  {
    u16* sB = smem;
    u16* sC = smem + 128 * 136;
    u16* sX = smem + 128 * 136;
    u16* sS = smem + 192 * 136;
    float* sac = (float*)(smem + 256 * 136);
    float* sdt = sac + 128;
    const float* alog = p.in[6]; const float* dsk = p.in[7];
    const int lrow = tid >> 4, lcol = (tid & 15) * 8;
    const int w = wave, l = 32 * w + lr;
    for (int t = bid; t < 512; t += nb) {
      const int b = t >> 7, c = (t >> 2) & 31, g = (t >> 1) & 1, half = t & 1;
      const int tok0 = b * 4096 + c * 128;
      {
        u32x4 bv[8], cv[8];
#pragma unroll
        for (int i = 0; i < 8; ++i) {
          bv[i] = *(const u32x4*)(BM + (size_t)(tok0 + lrow + 16 * i) * 256 + g * 128 + lcol);
          cv[i] = *(const u32x4*)(CM + (size_t)(tok0 + lrow + 16 * i) * 256 + g * 128 + lcol);
        }
        __syncthreads();
#pragma unroll
        for (int i = 0; i < 8; ++i) {
          *(u32x4*)(sB + (lrow + 16 * i) * 136 + lcol) = bv[i];
          *(u32x4*)(sC + (lrow + 16 * i) * 136 + lcol) = cv[i];
        }
        __syncthreads();
      }
      bf16x8 qf[8];
#pragma unroll
      for (int ks = 0; ks < 8; ++ks) qf[ks] = *(const bf16x8*)(sC + l * 136 + 16 * ks + 8 * hh);
#pragma unroll 1
      for (int hq = 0; hq < 4; ++hq) {
        const int h = g * 8 + half * 4 + hq;
        const int ti = (b * 32 + c) * 16 + h;
        const float aneg = -__expf(alog[h]);
        const float dskip = dsk[h];
        u32x4 xv[4], sv[4];
#pragma unroll
        for (int i = 0; i < 4; ++i) {
          xv[i] = *(const u32x4*)(XT + ((size_t)((b * 16 + h) * 64 + lrow + 16 * i)) * 4096 + c * 128 + lcol);
          sv[i] = *(const u32x4*)(STATES + (size_t)ti * 8192 + (lrow + 16 * i) * 128 + lcol);
        }
        float dtv = 0.f;
        if (tid < 128) dtv = DT[(size_t)(tok0 + tid) * 16 + h];
        __syncthreads();
#pragma unroll
        for (int i = 0; i < 4; ++i) {
          *(u32x4*)(sX + (lrow + 16 * i) * 136 + lcol) = xv[i];
          *(u32x4*)(sS + (lrow + 16 * i) * 136 + lcol) = sv[i];
        }
        if (tid < 128) { sdt[tid] = dtv; sac[tid] = dtv * aneg; }
        block_cumsum128(sac);
        const float al = sac[l];
        const float eal = __expf(al);
        uint2 zv[2][4];
#pragma unroll
        for (int pt = 0; pt < 2; ++pt)
#pragma unroll
          for (int q4 = 0; q4 < 4; ++q4) zv[pt][q4] = *(const uint2*)(Z + (size_t)(tok0 + l) * 1024 + h * 64 + 32 * pt + 8 * q4 + 4 * hh);
        f32x16 O[2];
#pragma unroll
        for (int r = 0; r < 16; ++r) { O[0][r] = 0.f; O[1][r] = 0.f; }
#pragma unroll
        for (int ks = 0; ks < 8; ++ks)
#pragma unroll
          for (int pt = 0; pt < 2; ++pt) O[pt] = MFMA(*(const bf16x8*)(sS + (32 * pt + lr) * 136 + 16 * ks + 8 * hh), qf[ks], O[pt]);
#pragma unroll
        for (int r = 0; r < 16; ++r) { O[0][r] *= eal; O[1][r] *= eal; }
#pragma unroll 1
        for (int st = 0; st < 4; ++st) {
          if (st <= w) {
            f32x16 Sx;
#pragma unroll
            for (int r = 0; r < 16; ++r) Sx[r] = 0.f;
#pragma unroll
            for (int ks = 0; ks < 8; ++ks) Sx = MFMA(*(const bf16x8*)(sB + (32 * st + lr) * 136 + 16 * ks + 8 * hh), qf[ks], Sx);
#pragma unroll
            for (int r = 0; r < 16; ++r) {
              const int s = 32 * st + crow(r, hh);
              float v = (s <= l) ? Sx[r] * __expf(al - sac[s]) * sdt[s] : 0.f;
              if (s == l) v += dskip;
              Sx[r] = v;
            }
#pragma unroll
            for (int s2 = 0; s2 < 2; ++s2) {
              bf16x8 pf = pack_frag(Sx, s2);
#pragma unroll
              for (int pt = 0; pt < 2; ++pt) O[pt] = MFMA(ld_frag8x2(sX + (32 * pt + lr) * 136 + 32 * st + 16 * s2 + 4 * hh), pf, O[pt]);
            }
          }
        }
#pragma unroll
        for (int pt = 0; pt < 2; ++pt)
#pragma unroll
          for (int q4 = 0; q4 < 4; ++q4) {
            u16* zp = Z + (size_t)(tok0 + l) * 1024 + h * 64 + 32 * pt + 8 * q4 + 4 * hh;
            const uint2 zz = zv[pt][q4];
            float y0 = O[pt][4 * q4 + 0] * siluf_(blo(zz.x));
            float y1 = O[pt][4 * q4 + 1] * siluf_(bhi(zz.x));
            float y2 = O[pt][4 * q4 + 2] * siluf_(blo(zz.y));
            float y3 = O[pt][4 * q4 + 3] * siluf_(bhi(zz.y));
            uint2 o; o.x = pk2(y0, y1); o.y = pk2(y2, y3);
            *(uint2*)zp = o;
          }
      }
    }
  }
  grid.sync();

  {
    const float* w0 = p.in[10]; const float* a0 = p.in[12];
    auto epiw = [&](int mw, int nw, f32x16 (&acc)[2][2]) __attribute__((always_inline)) {
#pragma unroll
      for (int i = 0; i < 2; ++i)
#pragma unroll
        for (int j = 0; j < 2; ++j) {
          const int n = nw + 32 * j + lr; const float w0n = w0[n];
#pragma unroll
          for (int r = 0; r < 16; ++r) {
            float wr = -softplusf_(-(w0n + acc[i][j][r])) - 0.5f;
            WE[(size_t)(mw + 32 * i + crow(r, hh)) * 1024 + n] = f2bf(__expf(wr));
          }
        }
    };
    auto epia = [&](int mw, int nw, f32x16 (&acc)[2][2]) __attribute__((always_inline)) {
#pragma unroll
      for (int i = 0; i < 2; ++i)
#pragma unroll
        for (int j = 0; j < 2; ++j) {
          const int n = nw + 32 * j + lr; const float a0n = a0[n];
#pragma unroll
          for (int r = 0; r < 16; ++r) AA[(size_t)(mw + 32 * i + crow(r, hh)) * 1024 + n] = f2bf(sigmoidf_(a0n + acc[i][j][r]));
        }
    };
    gemm_phase22(LIN, 256, LIN, 256, 64, W2T, 64, 64, M_, 1024, smem, epiw, bid, nb);
    gemm_phase22(LIN + 64, 256, LIN + 64, 256, 64, A2T, 64, 64, M_, 1024, smem, epia, bid, nb);
    gemm_phase22(LIN + 128, 256, LIN + 128, 256, 128, G2T, 128, 128, M_, 1024, smem, EpiBf16{GG, 1024, smem}, bid, nb);
  }
  grid.sync();

  {
    float* sr = smf; float* sw = sr + 2048; float* sk = sw + 2048; float* sa = sk + 2048; float* sb = sa + 2048;
    float* sv = sb + 2048;
    float* sy = sv + 512;
    const float* mu = p.in[9]; const float* kkp = p.in[15]; const float* kap = p.in[16];
    for (int rpt = 0; rpt < RPT_SCAN; ++rpt)
    for (int task = bid; task < 256; task += nb) {
      const int bhh = task >> 2, rq = task & 3, b = bhh >> 4, h = bhh & 15;
      const int pt_ = tid >> 3, jg = tid & 7, ch = h * 64 + 8 * jg;
      float mur[8], muk[8], muv[8], kkw[8], kaw[8];
#pragma unroll
      for (int q = 0; q < 8; ++q) { mur[q] = mu[ch + q]; muk[q] = mu[1024 + ch + q]; muv[q] = mu[2048 + ch + q]; kkw[q] = kkp[ch + q]; kaw[q] = kap[ch + q]; }
      const int row = tid >> 4, jq = tid & 15;
      float S0 = 0.f, S1 = 0.f, S2 = 0.f, S3 = 0.f;
      u32x4 gr, gk, gv, gpr, gpk, gpv, gwe, gaa;
#define ISSUE(tc_) { \
        const int s = (tc_) * 32 + pt_; \
        const size_t gt = (size_t)b * 4096 + s; \
        const u16* cur = RW + gt * 3328 + ch; \
        gr = *(const u32x4*)cur; gk = *(const u32x4*)(cur + 1024); gv = *(const u32x4*)(cur + 2048); \
        if (s > 0) { gpr = *(const u32x4*)(cur - 3328); gpk = *(const u32x4*)(cur - 3328 + 1024); gpv = *(const u32x4*)(cur - 3328 + 2048); } \
        else { gpr = (u32x4){0u, 0u, 0u, 0u}; gpk = gpr; gpv = gpr; } \
        gwe = *(const u32x4*)(WE + gt * 1024 + ch); gaa = *(const u32x4*)(AA + gt * 1024 + ch); }
      ISSUE(0);
      for (int tc = 0; tc < 128; ++tc) {
        __syncthreads();
        {
          float r[8], k[8], v[8], pr[8], pk[8], pv[8], we[8], aa[8];
          unpack8(gr, r); unpack8(gk, k); unpack8(gv, v); unpack8(gpr, pr); unpack8(gpk, pk); unpack8(gpv, pv); unpack8(gwe, we); unpack8(gaa, aa);
          float kk[8], ss = 0.f;
#pragma unroll
          for (int q = 0; q < 8; ++q) {
            r[q] += (pr[q] - r[q]) * mur[q]; k[q] += (pk[q] - k[q]) * muk[q]; v[q] += (pv[q] - v[q]) * muv[q];
            kk[q] = k[q] * kkw[q]; ss += kk[q] * kk[q];
          }
          ss += __shfl_xor(ss, 1); ss += __shfl_xor(ss, 2); ss += __shfl_xor(ss, 4);
          const float inv = rsqrtf(fmaxf(ss, 1e-24f));
          float o_w[8], o_k[8], o_a[8], o_b[8];
#pragma unroll
          for (int q = 0; q < 8; ++q) {
            kk[q] *= inv;
            o_w[q] = __expf(-we[q]);
            o_k[q] = k[q] * (1.f + (aa[q] - 1.f) * kaw[q]);
            o_a[q] = -kk[q]; o_b[q] = kk[q] * aa[q];
          }
          const int o = pt_ * 64 + 8 * jg;
          *(float4*)(sr + o) = make_float4(r[0], r[1], r[2], r[3]); *(float4*)(sr + o + 4) = make_float4(r[4], r[5], r[6], r[7]);
          *(float4*)(sw + o) = make_float4(o_w[0], o_w[1], o_w[2], o_w[3]); *(float4*)(sw + o + 4) = make_float4(o_w[4], o_w[5], o_w[6], o_w[7]);
          *(float4*)(sk + o) = make_float4(o_k[0], o_k[1], o_k[2], o_k[3]); *(float4*)(sk + o + 4) = make_float4(o_k[4], o_k[5], o_k[6], o_k[7]);
          *(float4*)(sa + o) = make_float4(o_a[0], o_a[1], o_a[2], o_a[3]); *(float4*)(sa + o + 4) = make_float4(o_a[4], o_a[5], o_a[6], o_a[7]);
          *(float4*)(sb + o) = make_float4(o_b[0], o_b[1], o_b[2], o_b[3]); *(float4*)(sb + o + 4) = make_float4(o_b[4], o_b[5], o_b[6], o_b[7]);
          if ((jg >> 1) == rq) {
            const int ov = pt_ * 16 + 8 * (jg & 1);
            *(float4*)(sv + ov) = make_float4(v[0], v[1], v[2], v[3]); *(float4*)(sv + ov + 4) = make_float4(v[4], v[5], v[6], v[7]);
          }
        }
        if (tc + 1 < 128) ISSUE(tc + 1);
        __syncthreads();
        {
          const int bit0 = jq & 1, bit1 = (jq >> 1) & 1;
#pragma unroll 4
          for (int t0 = 0; t0 < 32; t0 += 4) {
            float4 w4[4], k4[4], a4[4], b4[4], r4[4]; float vv[4];
#pragma unroll
            for (int u = 0; u < 4; ++u) {
              const int t = t0 + u;
              w4[u] = *(const float4*)(sw + t * 64 + 4 * jq);
              k4[u] = *(const float4*)(sk + t * 64 + 4 * jq);
              a4[u] = *(const float4*)(sa + t * 64 + 4 * jq);
              b4[u] = *(const float4*)(sb + t * 64 + 4 * jq);
              r4[u] = *(const float4*)(sr + t * 64 + 4 * jq);
              vv[u] = sv[t * 16 + row];
            }
            float yq[4];
#pragma unroll
            for (int u = 0; u < 4; ++u) {
              const float part = S0 * a4[u].x + S1 * a4[u].y + S2 * a4[u].z + S3 * a4[u].w;
              const float sa_ = row16_sum(part);
              S0 = S0 * w4[u].x + vv[u] * k4[u].x + sa_ * b4[u].x;
              S1 = S1 * w4[u].y + vv[u] * k4[u].y + sa_ * b4[u].y;
              S2 = S2 * w4[u].z + vv[u] * k4[u].z + sa_ * b4[u].z;
              S3 = S3 * w4[u].w + vv[u] * k4[u].w + sa_ * b4[u].w;
              yq[u] = S0 * r4[u].x + S1 * r4[u].y + S2 * r4[u].z + S3 * r4[u].w;
            }
            float u0 = bit0 ? yq[2] : yq[0], u1 = bit0 ? yq[3] : yq[1];
            const float s0 = bit0 ? yq[0] : yq[2], s1 = bit0 ? yq[1] : yq[3];
            u0 += dppf<0xB1>(s0); u1 += dppf<0xB1>(s1);
            float kq = bit1 ? u1 : u0; const float sq2 = bit1 ? u0 : u1;
            kq += dppf<0x4E>(sq2);
            kq += dppf<0x124>(kq);
            kq += dppf<0x128>(kq);
            if (jq < 4) sy[(t0 + 2 * bit0 + bit1) * 16 + row] = kq;
          }
        }
        __syncthreads();
        {
          const int t = tid >> 3, pr2 = tid & 7;
          const size_t gt = (size_t)b * 4096 + tc * 32 + t;
          *(unsigned*)(YR + gt * 1024 + h * 64 + 16 * rq + 2 * pr2) = pk2(sy[t * 16 + 2 * pr2], sy[t * 16 + 2 * pr2 + 1]);
        }
      }
    }
  }
  grid.sync();

  {
    const float* ng = p.in[8]; const float* mu = p.in[9]; const float* kap = p.in[16]; const float* rkp = p.in[17];
    const float* lg = p.in[18]; const float* lb = p.in[19];
    for (int tok = bid * 4 + wave; tok < M_; tok += nb * 4) {
      const int c0 = 16 * lane, s = tok & 4095;
      {
        u16* zp = Z + (size_t)tok * 1024 + c0;
        float y[16];
        unpack8(*(const uint4*)zp, y); unpack8(*(const uint4*)(zp + 8), y + 8);
        float ss = 0.f;
#pragma unroll
        for (int q = 0; q < 16; ++q) ss += y[q] * y[q];
#pragma unroll
        for (int o = 16; o > 0; o >>= 1) ss += __shfl_xor(ss, o);
        const float rs = rsqrtf(ss * (1.f / 512.f) + 1e-5f);
#pragma unroll
        for (int q = 0; q < 16; ++q) y[q] = y[q] * rs * ng[c0 + q];
        *(uint4*)zp = pack8(y); *(uint4*)(zp + 8) = pack8(y + 8);
      }
      {
        u16* yp = YR + (size_t)tok * 1024 + c0;
        float y[16], r[16], k[16], v[16], a[16], gg[16], tmp[16];
        unpack8(*(const uint4*)yp, y); unpack8(*(const uint4*)(yp + 8), y + 8);
        const u16* cur = RW + (size_t)tok * 3328 + c0;
        unpack8(*(const uint4*)cur, r); unpack8(*(const uint4*)(cur + 8), r + 8);
        unpack8(*(const uint4*)(cur + 1024), k); unpack8(*(const uint4*)(cur + 1032), k + 8);
        unpack8(*(const uint4*)(cur + 2048), v); unpack8(*(const uint4*)(cur + 2056), v + 8);
        if (s > 0) {
          const u16* prv = cur - 3328;
          unpack8(*(const uint4*)prv, tmp); unpack8(*(const uint4*)(prv + 8), tmp + 8);
#pragma unroll
          for (int q = 0; q < 16; ++q) r[q] += (tmp[q] - r[q]) * mu[c0 + q];
          unpack8(*(const uint4*)(prv + 1024), tmp); unpack8(*(const uint4*)(prv + 1032), tmp + 8);
#pragma unroll
          for (int q = 0; q < 16; ++q) k[q] += (tmp[q] - k[q]) * mu[1024 + c0 + q];
          unpack8(*(const uint4*)(prv + 2048), tmp); unpack8(*(const uint4*)(prv + 2056), tmp + 8);
#pragma unroll
          for (int q = 0; q < 16; ++q) v[q] += (tmp[q] - v[q]) * mu[2048 + c0 + q];
        } else {
#pragma unroll
          for (int q = 0; q < 16; ++q) { r[q] -= r[q] * mu[c0 + q]; k[q] -= k[q] * mu[1024 + c0 + q]; v[q] -= v[q] * mu[2048 + c0 + q]; }
        }
        const u16* ap = AA + (size_t)tok * 1024 + c0;
        unpack8(*(const uint4*)ap, a); unpack8(*(const uint4*)(ap + 8), a + 8);
        const u16* gp = GG + (size_t)tok * 1024 + c0;
        unpack8(*(const uint4*)gp, gg); unpack8(*(const uint4*)(gp + 8), gg + 8);
        float sm = 0.f, dot = 0.f;
#pragma unroll
        for (int q = 0; q < 16; ++q) {
          sm += y[q];
          const float k2 = k[q] * (1.f + (a[q] - 1.f) * kap[c0 + q]);
          dot += r[q] * k2 * rkp[c0 + q];
        }
        sm += __shfl_xor(sm, 1); sm += __shfl_xor(sm, 2);
        dot += __shfl_xor(dot, 1); dot += __shfl_xor(dot, 2);
        const float mean = sm * (1.f / 64.f);
        float vs = 0.f;
#pragma unroll
        for (int q = 0; q < 16; ++q) { const float d = y[q] - mean; vs += d * d; }
        vs += __shfl_xor(vs, 1); vs += __shfl_xor(vs, 2);
        const float rs = rsqrtf(vs * (1.f / 64.f) + 64e-5f);
#pragma unroll
        for (int q = 0; q < 16; ++q) y[q] = ((y[q] - mean) * rs * lg[c0 + q] + lb[c0 + q] + dot * v[q]) * gg[q];
        *(uint4*)yp = pack8(y); *(uint4*)(yp + 8) = pack8(y + 8);
      }
    }
  }
  grid.sync();

  gemm_phase22(Z, 1024, YR, 1024, 1024, WOUT, 2048, 2048, M_, 1024, smem, EpiResid{p.in[0], p.out}, bid, nb);
  grid.sync();

  ln_phase(p.out, p.in[23], p.in[24], XB, bid, nb);
  conv_weight(p.in[21], 1024, 3072, 3072, (u16*)(ws + OFF_QKV1), 0, smf, bid, nb);
  conv_weight(p.in[22], 1024, 1024, 1024, (u16*)(ws + OFF_OUT1), 0, smf, bid, nb);
  for (int l = 0; l < 2; ++l) {
    char* lw = ws + OFF_LW + LW_STRIDE * l;
    conv_weight(p.in[25] + (size_t)l * 1024 * 1024, 1024, 1024, 1024, (u16*)(lw + LW_WQ), 0, smf, bid, nb);
    conv_weight(p.in[26] + (size_t)l * 1024 * 2048, 1024, 2048, 2048, (u16*)(lw + LW_WKV), 0, smf, bid, nb);
    conv_weight(p.in[27] + (size_t)l * 1024 * 1024, 1024, 1024, 1024, (u16*)(lw + LW_WO), 0, smf, bid, nb);
    conv_weight(p.in[30] + (size_t)l * 1024 * 2 * FFN_H, 1024, 2 * FFN_H, 2 * FFN_H, (u16*)(lw + LW_W13), 1, smf, bid, nb);
    conv_weight(p.in[31] + (size_t)l * FFN_H * 1024, FFN_H, 1024, 1024, (u16*)(lw + LW_W2F), 0, smf, bid, nb);
  }
  grid.sync();

  xattn_ffn(p, 0, grid, smem, bid, nb, true);

  {
    u16* Q1 = (u16*)(ws + OFF_S0); u16* K1 = (u16*)(ws + OFF_S1); u16* V1T = (u16*)(ws + OFF_S2); u16* O1 = (u16*)(ws + OFF_S3);
    {
      auto epi = [&](int mw, int nw, f32x16 (&acc)[2][2]) __attribute__((always_inline)) {
        const int wv = tid >> 6;
        const int m0 = mw - (wv >> 1) * 64, n0 = nw - (wv & 1) * 64;
        if (n0 < 2048) {
          u16* dst = (n0 < 1024) ? Q1 : K1;
          const int nn = n0 & 1023;
          stage_tile<0>(acc, smem, [&](int rr, int cc, const u32x4& v) __attribute__((always_inline)) { *(u32x4*)(dst + (size_t)(m0 + rr) * 1024 + nn + cc) = v; });
        } else {
          stage_tile<1>(acc, smem, [&](int rr, int cc, const u32x4& v) __attribute__((always_inline)) {
            const int c = n0 - 2048 + rr, m = m0 + cc;
            *(u32x4*)(V1T + ((size_t)((m >> 12) * 1024 + c)) * 4096 + (m & 4095)) = v;
          });
        }
      };
      gemm_phase22(XB, 1024, XB, 1024, 1024, (const u16*)(ws + OFF_QKV1), 1024, 1024, M_, 3072, smem, epi, bid, nb);
    }
    grid.sync();
    for (int t = bid; t < 1024; t += nb) {
      const int bhh = t >> 4, blk = t & 15, b = bhh >> 4, h = bhh & 15;
      const int d = tid & 63, part = tid >> 6;
      float s = 0.f;
      const u16* src = K1 + ((size_t)b * 4096 + blk * 256 + part * 64) * 1024 + h * 64 + d;
      for (int i = 0; i < 64; ++i) s += bf2f(src[(size_t)i * 1024]);
      __syncthreads();
      smf[part * 64 + d] = s;
      __syncthreads();
      if (tid < 64) KMEAN[(size_t)t * 64 + tid] = (smf[tid] + smf[64 + tid] + smf[128 + tid] + smf[192 + tid]) * (1.f / 256.f);
    }
    grid.sync();
    {
      float* skm = smf;
      int* slist = (int*)(smf + 1024);
      u16* sKV = smem + 4096;
      for (int rpt = 0; rpt < RPT_MOBA; ++rpt)
      for (int t = bid; t < 2048; t += nb) {
        const int rnd = t >> 9, g8 = (t >> 6) & 7;
        const int qt = (rnd == 0) ? 31 - g8 : (rnd == 1) ? g8 : (rnd == 2) ? 23 - g8 : 8 + g8;
        const int bhh = t & 63, b = bhh >> 4, h = bhh & 15, own = qt >> 1;
        __syncthreads();
        for (int i = tid; i < 1024; i += 256) skm[i] = KMEAN[(size_t)bhh * 1024 + i];
        if (tid == 0) slist[65] = 0;
        __syncthreads();
        const int sq = qt * 128 + 32 * wave + lr;
        const size_t tokq = (size_t)b * 4096 + sq;
        bf16x8 qf[4];
#pragma unroll
        for (int ks = 0; ks < 4; ++ks) qf[ks] = ld_frag16(Q1 + tokq * 1024 + h * 64 + 16 * ks + 8 * hh);
        unsigned sel = 0;
        {
          float qv[32];
#pragma unroll
          for (int i = 0; i < 4; ++i) unpack8(*(const u32x4*)(Q1 + tokq * 1024 + h * 64 + 32 * hh + 8 * i), qv + 8 * i);
          float v0 = -INFINITY, v1 = -INFINITY, v2 = -INFINITY; int i0 = -1, i1 = -1, i2 = -1;
          for (int n = 0; n < own; ++n) {
            float part = 0.f;
#pragma unroll
            for (int d = 0; d < 32; ++d) part += qv[d] * skm[n * 64 + 32 * hh + d];
            const float gsc = part + __shfl_xor(part, 32);
            if (gsc > v0) { v2 = v1; i2 = i1; v1 = v0; i1 = i0; v0 = gsc; i0 = n; }
            else if (gsc > v1) { v2 = v1; i2 = i1; v1 = gsc; i1 = n; }
            else if (gsc > v2) { v2 = gsc; i2 = n; }
          }
          if (i0 >= 0) sel |= 1u << i0;
          if (i1 >= 0) sel |= 1u << i1;
          if (i2 >= 0) sel |= 1u << i2;
        }
        unsigned wsel = sel;
#pragma unroll
        for (int o = 1; o < 64; o <<= 1) wsel |= (unsigned)__shfl_xor((int)wsel, o);
        if (lane == 0) atomicOr((unsigned*)&slist[65], wsel);
        __syncthreads();
        if (tid == 0) {
          const unsigned bm = (unsigned)slist[65];
          int n = 0;
          for (int j = 0; j < own; ++j)
            if ((bm >> j) & 1u) for (int kt = 0; kt < 4; ++kt) slist[n++] = (j << 8) | kt;
          const int nown = (qt & 1) * 2 + 2;
          for (int kt = 0; kt < nown; ++kt) slist[n++] = (own << 8) | kt;
          slist[64] = n;
        }
        __syncthreads();
        const int ntile = slist[64];
        f32x16 O[2];
#pragma unroll
        for (int r = 0; r < 16; ++r) { O[0][r] = 0.f; O[1][r] = 0.f; }
        float mrun = -1e30f, lrun = 0.f;
        u32x4 gk0, gk1, gv0, gv1;
        const int lrow = tid >> 2, lcol = (tid & 3) * 16;
#define KV_LOAD(e_) { const int j_ = (e_) >> 8, kt_ = (e_) & 255; const int key0_ = j_ * 256 + kt_ * 64; \
          const u16* kp_ = K1 + ((size_t)b * 4096 + key0_ + lrow) * 1024 + h * 64 + lcol; gk0 = *(const u32x4*)kp_; gk1 = *(const u32x4*)(kp_ + 8); \
          const u16* vp_ = V1T + ((size_t)(bhh * 64 + lrow)) * 4096 + key0_ + lcol; gv0 = *(const u32x4*)vp_; gv1 = *(const u32x4*)(vp_ + 8); }
#define KV_STORE(buf_) { u16* kb_ = sKV + (buf_) * 9216; *(u32x4*)(kb_ + lrow * 72 + lcol) = gk0; *(u32x4*)(kb_ + lrow * 72 + lcol + 8) = gk1; \
          u16* vb_ = kb_ + 4608; *(u32x4*)(vb_ + lrow * 72 + lcol) = gv0; *(u32x4*)(vb_ + lrow * 72 + lcol + 8) = gv1; }
        KV_LOAD(slist[0]);
        KV_STORE(0);
        __syncthreads();
        const float SC = 0.125f * 1.44269504088896f;
        for (int i = 0; i < ntile; ++i) {
          const int e = slist[i]; const int j = e >> 8, kt = e & 255;
          const bool more = (i + 1 < ntile);
          if (more) KV_LOAD(slist[i + 1]);
          const bool isown = (j == own);
          const bool lsel = isown || ((sel >> j) & 1u);
          const bool wact = isown || ((wsel >> j) & 1u);
          if (wact) {
            const u16* kb = sKV + (i & 1) * 9216; const u16* vb = kb + 4608;
#pragma unroll
            for (int sub = 0; sub < 2; ++sub) {
              const int key0 = j * 256 + kt * 64 + 32 * sub;
              if (isown && key0 > qt * 128 + 32 * wave + 31) continue;
              f32x16 Sx;
#pragma unroll
              for (int r = 0; r < 16; ++r) Sx[r] = 0.f;
              __builtin_amdgcn_s_setprio(1);
#pragma unroll
              for (int ks = 0; ks < 4; ++ks) {
                bf16x8 kf = *(const bf16x8*)(kb + (32 * sub + lr) * 72 + 16 * ks + 8 * hh);
                Sx = MFMA(kf, qf[ks], Sx);
              }
              __builtin_amdgcn_s_setprio(0);
              float tmx = -1e30f, ls = 0.f, mnew, alpha;
              if (isown) {
#pragma unroll
                for (int r = 0; r < 16; ++r) {
                  Sx[r] *= SC;
                  if (key0 + crow(r, hh) <= sq) tmx = fmaxf(tmx, Sx[r]);
                }
                tmx = fmaxf(tmx, __shfl_xor(tmx, 32));
                mnew = fmaxf(mrun, tmx);
                alpha = __builtin_amdgcn_exp2f(mrun - mnew);
#pragma unroll
                for (int r = 0; r < 16; ++r) {
                  const float pe = (key0 + crow(r, hh) <= sq) ? __builtin_amdgcn_exp2f(Sx[r] - mnew) : 0.f;
                  Sx[r] = pe; ls += pe;
                }
              } else {
#pragma unroll
                for (int r = 0; r < 16; ++r) tmx = fmaxf(tmx, Sx[r]);
                tmx = lsel ? tmx * SC : -1e30f;
                tmx = fmaxf(tmx, __shfl_xor(tmx, 32));
                mnew = fmaxf(mrun, tmx);
                alpha = __builtin_amdgcn_exp2f(mrun - mnew);
                const float lm = lsel ? 1.f : 0.f;
#pragma unroll
                for (int r = 0; r < 16; ++r) {
                  const float pe = __builtin_amdgcn_exp2f(fminf(__builtin_fmaf(Sx[r], SC, -mnew), 0.f)) * lm;
                  Sx[r] = pe; ls += pe;
                }
              }
              ls += __shfl_xor(ls, 32);
              lrun = lrun * alpha + ls; mrun = mnew;
#pragma unroll
              for (int r = 0; r < 16; ++r) { O[0][r] *= alpha; O[1][r] *= alpha; }
#pragma unroll
              for (int s2 = 0; s2 < 2; ++s2) {
                bf16x8 pf = pack_frag(Sx, s2);
#pragma unroll
                for (int dt = 0; dt < 2; ++dt) {
                  bf16x8 af = ld_frag8x2(vb + (32 * dt + lr) * 72 + 32 * sub + 16 * s2 + 4 * hh);
                  O[dt] = MFMA(af, pf, O[dt]);
                }
              }
            }
          }
          if (more) KV_STORE((i + 1) & 1);
          __syncthreads();
        }
        const float inv = 1.f / lrun;
#pragma unroll
        for (int dt = 0; dt < 2; ++dt)
#pragma unroll
          for (int q4 = 0; q4 < 4; ++q4) {
            uint2 o; o.x = pk2(O[dt][4 * q4] * inv, O[dt][4 * q4 + 1] * inv); o.y = pk2(O[dt][4 * q4 + 2] * inv, O[dt][4 * q4 + 3] * inv);
            *(uint2*)(O1 + tokq * 1024 + h * 64 + 32 * dt + 8 * q4 + 4 * hh) = o;
          }
      }
    }
    grid.sync();
    gemm_phase22(O1, 1024, O1, 1024, 1024, (const u16*)(ws + OFF_OUT1), 1024, 1024, M_, 1024, smem, EpiResid{p.out, p.out}, bid, nb);
    grid.sync();
    ln_phase(p.out, p.in[23] + 1024, p.in[24] + 1024, XB, bid, nb);
    grid.sync();
  }
  xattn_ffn(p, 1, grid, smem, bid, nb, true);
}

extern "C" void kernel_launch(void* const* d_in, const int* in_sizes, int n_in, void* d_out, int out_size, void* d_ws, size_t ws_size,
                              hipStream_t stream) {
  static int grid_blocks = 0;
  if (!grid_blocks) {
    int dev = 0, cus = 0, per_cu = 0;
    hipGetDevice(&dev);
    hipDeviceGetAttribute(&cus, hipDeviceAttributeMultiprocessorCount, dev);
    hipOccupancyMaxActiveBlocksPerMultiprocessor(&per_cu, fwd_megakernel, 256, 0);
    if (per_cu > 2) per_cu = 2;
    if (per_cu < 1) per_cu = 1;
    grid_blocks = cus * per_cu;
  }
  Params p{};
  for (int i = 0; i < 34; ++i) p.in[i] = (const float*)d_in[i];
  p.out = (float*)d_out;
  p.ws = (char*)d_ws;
  hipMemsetAsync((char*)d_ws + OFF_BAR, 0, XCD_BAR_WORDS * sizeof(unsigned), stream);
  void* args[] = {&p};
  hipError_t e = hipLaunchCooperativeKernel((void*)fwd_megakernel, dim3(grid_blocks), dim3(256), args, 0, stream);
  if (e != hipSuccess) fprintf(stderr, "cooperative launch failed: %s (grid %d)\n", hipGetErrorString(e), grid_blocks);
}
```
